# Optimizing an MI355X kernel written in HIP

```python
import math
import jax
import jax.numpy as jnp
from jax import lax
import numpy as np

D_MODEL = 2048
BATCH = 2
SEQ = 4096
DEPTH = 1

CTX_LEN = 256
GRID_W = 64
S5_WIDTH = D_MODEL // 2
S5_GROUP = 16
S5_GROUPS = S5_WIDTH // S5_GROUP
S5_STATE = 64
RWKV_WIDTH = D_MODEL // 2
RWKV_HEAD = 64
RWKV_HEADS = RWKV_WIDTH // RWKV_HEAD
DECAY_LORA = 64
ICLR_LORA = 64
GATE_LORA = 128
RWKV_SHIFT_COLS = 3 * RWKV_WIDTH + 2 * DECAY_LORA + 2 * ICLR_LORA + GATE_LORA
IN_COLS = S5_WIDTH + RWKV_SHIFT_COLS + 2 * D_MODEL
D_FF = -(-(8 * D_MODEL) // (3 * 256)) * 256
N_MOD = 6
NORM_EPS = 1e-6
GN_EPS = 64e-5
DT_MIN = 1e-3
DT_MAX = 1e-1

kernel_name = 'hybrid_s5_rwkv7_flow_block'


def rms_norm(x, w):
    xf = x.astype(jnp.float32)
    y = xf * lax.rsqrt(jnp.mean(xf * xf, axis=-1, keepdims=True) + NORM_EPS)
    return (y * w.astype(jnp.float32)).astype(x.dtype)


def modulate(h, shift, scale):
    return h * (1 + scale) + shift


def grid_neighbour_mean(z):
    bsz, length, ch = z.shape
    rows = length // GRID_W
    g = z.reshape(bsz, rows, GRID_W, ch)
    p = jnp.pad(g, ((0, 0), (1, 1), (1, 1), (0, 0)))
    s = p[:, :-2, 1:-1] + p[:, 2:, 1:-1] + p[:, 1:-1, :-2] + p[:, 1:-1, 2:]
    ri = jnp.arange(rows)
    ci = jnp.arange(GRID_W)
    cnt = ((ri > 0).astype(z.dtype) + (ri < rows - 1).astype(z.dtype))[:, None] + ((ci > 0).astype(z.dtype) + (ci < GRID_W - 1).astype(z.dtype))[None, :]
    return (s / cnt[None, :, :, None]).reshape(bsz, length, ch)


def seq_neighbour_mean(z):
    length = z.shape[1]
    p = jnp.pad(z, ((0, 0), (1, 1), (0, 0)))
    i = jnp.arange(length)
    cnt = (i > 0).astype(z.dtype) + (i < length - 1).astype(z.dtype)
    return (p[:, :-2] + p[:, 2:]) / cnt[None, :, None]


def _complex(re, im):
    return lax.complex(re.astype(jnp.float32), im.astype(jnp.float32))


def s5_scan(bu, abar, s0):
    a = jnp.broadcast_to(abar, (bu.shape[0], 1) + abar.shape)

    def combine(e1, e2):
        a1, b1 = e1
        a2, b2 = e2
        return a1 * a2, a2 * b1 + b2

    a_cum, b_cum = lax.associative_scan(combine, (a, bu), axis=0)
    return b_cum + a_cum * s0[None]


def s5_mixer(u, lp, s0):
    bsz, length, _ = u.shape
    ug = jnp.swapaxes(u.astype(jnp.float32).reshape(bsz, length, S5_GROUPS, S5_GROUP), 0, 1)
    ugc = ug.astype(jnp.complex64)
    y = lp['s5_d'].astype(jnp.float32) * ug
    finals = []
    for di in range(2):
        a = _complex(lp['s5_a_re'][di], lp['s5_a_im'][di])
        dt = jnp.exp(lp['s5_log_dt'][di].astype(jnp.float32))[:, None]
        abar = jnp.exp(a * dt)
        bbar = ((abar - 1) / a)[..., None] * _complex(lp['s5_b_re'][di], lp['s5_b_im'][di])
        bu = jnp.einsum('lbgh,gph->lbgp', ugc, bbar)
        if di == 1:
            bu = bu[::-1]
        states = s5_scan(bu, abar, s0[di])
        finals.append(states[-1])
        if di == 1:
            states = states[::-1]
        cm = _complex(lp['s5_c_re'][di], lp['s5_c_im'][di])
        y = y + jnp.real(jnp.einsum('lbgp,ghp->lbgh', states, cm))
    y = jnp.swapaxes(y, 0, 1).reshape(bsz, length, S5_WIDTH)
    return y.astype(u.dtype), (finals[0], finals[1])


def rwkv_scan(r, w, k, v, kk, a, s0):
    def step(s, inp):
        r_t, w_t, k_t, v_t, kk_t, a_t = inp
        s_kk = jnp.einsum('bhvk,bhk->bhv', s, kk_t)
        s = s * w_t[:, :, None, :] - s_kk[..., None] * (kk_t * a_t)[:, :, None, :] + v_t[..., None] * k_t[:, :, None, :]
        return s, jnp.einsum('bhvk,bhk->bhv', s, r_t)

    s_fin, y = lax.scan(step, s0, (r, w, k, v, kk, a))
    return y, s_fin


def rwkv_mixer(z, lp, s0):
    bsz, length, _ = z.shape
    zf = z.astype(jnp.float32)
    rw = RWKV_WIDTH
    r = zf[..., :rw]
    k = zf[..., rw:2 * rw]
    v = zf[..., 2 * rw:3 * rw]
    o = 3 * rw
    wd = zf[..., o:o + 2 * DECAY_LORA].reshape(bsz, length, 2, DECAY_LORA)
    o += 2 * DECAY_LORA
    ad = zf[..., o:o + 2 * ICLR_LORA].reshape(bsz, length, 2, ICLR_LORA)
    o += 2 * ICLR_LORA
    gd = zf[..., o:o + GATE_LORA]
    g = jax.nn.sigmoid(gd) @ lp['rw_g2'].astype(jnp.float32)

    def heads(t):
        return jnp.swapaxes(t.reshape(bsz, length, RWKV_HEADS, RWKV_HEAD), 0, 1)

    kk = heads(k * lp['rw_k_k'].astype(jnp.float32))
    kk = kk * lax.rsqrt(jnp.sum(kk * kk, axis=-1, keepdims=True) + 1e-12)
    r_h = heads(r)
    v_h = heads(v)
    r_k = lp['rw_r_k'].astype(jnp.float32)
    ys = []
    bonuses = []
    finals = []
    for di in range(2):
        w = -jax.nn.softplus(-(lp['rw_w0'][di].astype(jnp.float32) + jnp.tanh(wd[:, :, di]) @ lp['rw_w2'][di].astype(jnp.float32))) - 0.5
        decay = jnp.exp(-jnp.exp(w))
        a = jax.nn.sigmoid(lp['rw_a0'][di].astype(jnp.float32) + ad[:, :, di] @ lp['rw_a2'][di].astype(jnp.float32))
        k_d = heads(k * (1 + (a - 1) * lp['rw_k_a'].astype(jnp.float32)))
        seqs = (r_h, heads(decay), k_d, v_h, kk, heads(a))
        if di == 1:
            seqs = tuple(t[::-1] for t in seqs)
        y_d, s_fin = rwkv_scan(*seqs, s0[di])
        if di == 1:
            y_d = y_d[::-1]
        ys.append(y_d)
        bonuses.append(jnp.sum(r_h * k_d * r_k, axis=-1, keepdims=True) * v_h)
        finals.append(s_fin)
    y = ys[0] + ys[1]
    mu = jnp.mean(y, axis=-1, keepdims=True)
    var = jnp.mean(jnp.square(y - mu), axis=-1, keepdims=True)
    y = (y - mu) * lax.rsqrt(var + GN_EPS)
    ln_w = lp['rw_ln_w'].astype(jnp.float32).reshape(RWKV_HEADS, RWKV_HEAD)
    ln_b = lp['rw_ln_b'].astype(jnp.float32).reshape(RWKV_HEADS, RWKV_HEAD)
    y = y * ln_w + ln_b + bonuses[0] + bonuses[1]
    y = jnp.swapaxes(y, 0, 1).reshape(bsz, length, rw) * g
    return y.astype(z.dtype), (finals[0], finals[1])


def token_mix(h, neighbour_mean, s5_init, rw_init, lp, with_output):
    z = jnp.einsum('bld,dc->blc', h, lp['w_in'])
    u_s5 = z[..., :S5_WIDTH]
    z_rw = z[..., S5_WIDTH:S5_WIDTH + RWKV_SHIFT_COLS]
    z_rw = z_rw + (neighbour_mean(z_rw) - z_rw) * lp['rw_mu']
    y_s5, s5_fin = s5_mixer(u_s5, lp, s5_init)
    y_rw, rw_fin = rwkv_mixer(z_rw, lp, rw_init)
    if not with_output:
        return None, s5_fin, rw_fin
    gates = jax.nn.sigmoid(z[..., S5_WIDTH + RWKV_SHIFT_COLS:])
    glu = jax.nn.gelu(y_s5) @ lp['s5_glu_w']
    s5_out = glu[..., :D_MODEL] * jax.nn.sigmoid(glu[..., D_MODEL:])
    rw_out = y_rw @ lp['rw_proj']
    merged = gates[..., :D_MODEL] * s5_out + gates[..., D_MODEL:] * rw_out
    return merged @ lp['w_o'], s5_fin, rw_fin


def swiglu(h, w13, w2):
    z = h @ w13
    return (jax.nn.silu(z[..., :D_FF]) * z[..., D_FF:]) @ w2


def setup_inputs(seed: int = 0) -> dict:
    key = jax.random.key(seed)
    ks = jax.random.split(key, 40)

    def nrm(k, shape, s):
        return jax.random.normal(k, shape, jnp.float32) * s

    dp = DEPTH
    g_, p_, hg = S5_GROUPS, S5_STATE, S5_GROUP
    a_im_base = math.pi * jnp.arange(p_, dtype=jnp.float32)
    return {
        'x': nrm(ks[0], (BATCH, SEQ, D_MODEL), 1.0),
        'c': nrm(ks[1], (BATCH, D_MODEL), 1.0),
        'ctx': nrm(ks[2], (BATCH, CTX_LEN, D_MODEL), 1.0),
        'c_ctx': nrm(ks[3], (D_MODEL,), 1.0),
        'ada_w': nrm(ks[4], (dp, D_MODEL, N_MOD * D_MODEL), 0.5 * D_MODEL ** -0.5),
        'ada_b': nrm(ks[5], (dp, N_MOD * D_MODEL), 0.02),
        'norm1_w': 1.0 + nrm(ks[6], (dp, D_MODEL), 0.02),
        'w_in': nrm(ks[7], (dp, D_MODEL, IN_COLS), D_MODEL ** -0.5),
        'rw_mu': jax.random.uniform(ks[8], (dp, RWKV_SHIFT_COLS), jnp.float32),
        's5_a_re': -0.5 + nrm(ks[9], (dp, 2, g_, p_), 0.01),
        's5_a_im': a_im_base + nrm(ks[10], (dp, 2, g_, p_), 0.01),
        's5_log_dt': jax.random.uniform(ks[11], (dp, 2, g_), jnp.float32, math.log(DT_MIN), math.log(DT_MAX)),
        's5_b_re': nrm(ks[12], (dp, 2, g_, p_, hg), (2 * hg) ** -0.5),
        's5_b_im': nrm(ks[13], (dp, 2, g_, p_, hg), (2 * hg) ** -0.5),
        's5_c_re': nrm(ks[14], (dp, 2, g_, hg, p_), (2 * p_) ** -0.5),
        's5_c_im': nrm(ks[15], (dp, 2, g_, hg, p_), (2 * p_) ** -0.5),
        's5_d': nrm(ks[16], (dp, g_, hg), 1.0),
        's5_glu_w': nrm(ks[17], (dp, S5_WIDTH, 2 * D_MODEL), S5_WIDTH ** -0.5),
        'rw_w0': jax.random.uniform(ks[18], (dp, 2, RWKV_WIDTH), jnp.float32, -6.0, -1.0),
        'rw_w2': nrm(ks[19], (dp, 2, DECAY_LORA, RWKV_WIDTH), 0.1 * DECAY_LORA ** -0.5),
        'rw_a0': nrm(ks[20], (dp, 2, RWKV_WIDTH), 0.1),
        'rw_a2': nrm(ks[21], (dp, 2, ICLR_LORA, RWKV_WIDTH), 0.1 * ICLR_LORA ** -0.5),
        'rw_g2': nrm(ks[22], (dp, GATE_LORA, RWKV_WIDTH), GATE_LORA ** -0.5),
        'rw_k_k': 0.85 + nrm(ks[23], (dp, RWKV_WIDTH), 0.02),
        'rw_k_a': 1.0 + nrm(ks[24], (dp, RWKV_WIDTH), 0.02),
        'rw_r_k': nrm(ks[25], (dp, RWKV_HEADS, RWKV_HEAD), 0.1),
        'rw_ln_w': 1.0 + nrm(ks[26], (dp, RWKV_WIDTH), 0.02),
        'rw_ln_b': nrm(ks[27], (dp, RWKV_WIDTH), 0.02),
        'rw_proj': nrm(ks[28], (dp, RWKV_WIDTH, D_MODEL), RWKV_WIDTH ** -0.5),
        'w_o': nrm(ks[29], (dp, D_MODEL, D_MODEL), D_MODEL ** -0.5),
        'norm2_w': 1.0 + nrm(ks[30], (dp, D_MODEL), 0.02),
        'ffn_w13': nrm(ks[31], (dp, D_MODEL, 2 * D_FF), D_MODEL ** -0.5),
        'ffn_w2': nrm(ks[32], (dp, D_FF, D_MODEL), D_FF ** -0.5),
        'norm_f': 1.0 + nrm(ks[33], (D_MODEL,), 0.02),
    }


def reference(x, c, ctx, c_ctx, ada_w, ada_b, norm1_w, w_in, rw_mu, s5_a_re, s5_a_im, s5_log_dt,
              s5_b_re, s5_b_im, s5_c_re, s5_c_im, s5_d, s5_glu_w, rw_w0, rw_w2, rw_a0, rw_a2, rw_g2,
              rw_k_k, rw_k_a, rw_r_k, rw_ln_w, rw_ln_b, rw_proj, w_o, norm2_w, ffn_w13, ffn_w2, norm_f):
    bsz = x.shape[0]
    s5_zero = jnp.zeros((bsz, S5_GROUPS, S5_STATE), jnp.complex64)
    rw_zero = jnp.zeros((bsz, RWKV_HEADS, RWKV_HEAD, RWKV_HEAD), jnp.float32)
    h_lat = x
    h_ctx = ctx
    for i in range(DEPTH):
        lp = {
            'w_in': w_in[i], 'rw_mu': rw_mu[i],
            's5_a_re': s5_a_re[i], 's5_a_im': s5_a_im[i], 's5_log_dt': s5_log_dt[i],
            's5_b_re': s5_b_re[i], 's5_b_im': s5_b_im[i], 's5_c_re': s5_c_re[i], 's5_c_im': s5_c_im[i],
            's5_d': s5_d[i], 's5_glu_w': s5_glu_w[i],
            'rw_w0': rw_w0[i], 'rw_w2': rw_w2[i], 'rw_a0': rw_a0[i], 'rw_a2': rw_a2[i], 'rw_g2': rw_g2[i],
            'rw_k_k': rw_k_k[i], 'rw_k_a': rw_k_a[i], 'rw_r_k': rw_r_k[i],
            'rw_ln_w': rw_ln_w[i], 'rw_ln_b': rw_ln_b[i], 'rw_proj': rw_proj[i], 'w_o': w_o[i],
        }
        last = i == DEPTH - 1
        mod = jax.nn.silu(c) @ ada_w[i] + ada_b[i]
        mod_c = jax.nn.silu(c_ctx) @ ada_w[i] + ada_b[i]
        sh1, sc1, g1, sh2, sc2, g2 = jnp.split(mod[:, None, :], N_MOD, axis=-1)
        sh1c, sc1c, g1c, sh2c, sc2c, g2c = jnp.split(mod_c, N_MOD, axis=-1)
        ctx_out, s5_ctx, rw_ctx = token_mix(modulate(rms_norm(h_ctx, norm1_w[i]), sh1c, sc1c), seq_neighbour_mean,
                                            (s5_zero, s5_zero), (rw_zero, rw_zero), lp, not last)
        lat_out, _, _ = token_mix(modulate(rms_norm(h_lat, norm1_w[i]), sh1, sc1), grid_neighbour_mean,
                                  s5_ctx, rw_ctx, lp, True)
        h_lat = h_lat + g1 * lat_out
        h_lat = h_lat + g2 * swiglu(modulate(rms_norm(h_lat, norm2_w[i]), sh2, sc2), ffn_w13[i], ffn_w2[i])
        if not last:
            h_ctx = h_ctx + g1c * ctx_out
            h_ctx = h_ctx + g2c * swiglu(modulate(rms_norm(h_ctx, norm2_w[i]), sh2c, sc2c), ffn_w13[i], ffn_w2[i])
    return rms_norm(h_lat, norm_f)
```

```cpp
#include <hip/hip_runtime.h>
#include <hip/hip_cooperative_groups.h>
#include <cstdio>
namespace cg = cooperative_groups;

#ifndef ONE_LAUNCH
#define ONE_LAUNCH 1
#endif

typedef unsigned short u16;
typedef _Float16 h16;
using bf16x8 = __attribute__((ext_vector_type(8))) short;
using f32x4 = __attribute__((ext_vector_type(4))) float;
using h16x2 = __attribute__((ext_vector_type(2))) _Float16;
using h16x8 = __attribute__((ext_vector_type(8))) _Float16;
#define DEVI __device__ __forceinline__

constexpr int NLAT = 8192, NTOK = 8704;
constexpr int ZRWP = 3584;
constexpr int DFF = 5632;
constexpr int GS = 544 * 512;
constexpr int NTHR = 512;

constexpr size_t ARRB = 17825792;
constexpr size_t OFF_MOD = 0;
constexpr size_t OFF_BAR = 147456;
constexpr size_t OFF_GLUT = 147456 + 256;
constexpr size_t OFF_RWPT = OFF_GLUT + 8388608;
constexpr size_t OFF_WOT = OFF_RWPT + 4194304;
constexpr size_t OFF_LORAT = OFF_WOT + 8388608;
constexpr size_t OFF_BMAT = OFF_LORAT + 3932160;
constexpr size_t OFF_KC = OFF_BMAT + 8388608;
constexpr size_t OFF_LA = OFF_KC + 16777216;
constexpr size_t OFF_A = OFF_LA + 6684672;
constexpr size_t OFF_B = OFF_A + 35651584;
constexpr size_t OFF_FX = OFF_B + 35651584;
constexpr size_t OFF_C = OFF_FX + 89128960;
constexpr size_t OFF_D = OFF_C + 35880960;
constexpr size_t OFF_E = OFF_D + 62390272;
constexpr size_t OFF_XB = OFF_E + 67108864;
constexpr size_t OFF_W2T = OFF_XB + 16384;
constexpr size_t OFF_W13A = OFF_W2T + 23068672;
constexpr int W13A_TILES = 19;
constexpr size_t WS_END = OFF_W13A + (size_t)W13A_TILES * 256 * 2048 * 2;

struct Params {
  const float* in[34];
  float* out;
  unsigned char* ws;
  int ph_lo, ph_hi;
};
typedef const __attribute__((address_space(4))) Params* KP;

enum { I_X = 0, I_C, I_CTX, I_CCTX, I_ADAW, I_ADAB, I_N1W, I_WIN, I_MU, I_SARE, I_SAIM, I_SLDT, I_SBRE, I_SBIM, I_SCRE, I_SCIM,
       I_SD, I_GLUW, I_W0, I_W2, I_A0, I_A2, I_G2, I_KK, I_KA, I_RK, I_LNW, I_LNB, I_RWP, I_WO, I_N2W, I_W13, I_FW2, I_NF };

DEVI float4 ldnt4(const float* q) { f32x4 v = __builtin_nontemporal_load((const f32x4*)q); return make_float4(v[0], v[1], v[2], v[3]); }
DEVI int lane_id_opaque() { int r; asm volatile("v_mbcnt_lo_u32_b32 %0, -1, 0\n\tv_mbcnt_hi_u32_b32 %0, -1, %0" : "=v"(r)); return r; }
DEVI u16 f2bf(float f) { unsigned u = __float_as_uint(f); u += 0x7fffu + ((u >> 16) & 1u); return (u16)(u >> 16); }
DEVI float bf2f(u16 h) { return __uint_as_float(((unsigned)h) << 16); }
DEVI float sigm(float x) { return 1.f / (1.f + __expf(-x)); }
DEVI float tanh_(float x) { float e = __expf(2.f * x); return 1.f - 2.f / (1.f + e); }
DEVI float gelu_tanh(float x) { float u = 0.7978845608028654f * (x + 0.044715f * x * x * x); return 0.5f * x * (1.f + tanh_(u)); }
DEVI float silu_(float x) { return x / (1.f + __expf(-x)); }
template <int CTRL> DEVI float dppf(float x) {
  return __builtin_bit_cast(float, __builtin_amdgcn_update_dpp(0, __builtin_bit_cast(int, x), CTRL, 0xF, 0xF, false));
}
DEVI float red16(float x) { x += dppf<0xB1>(x); x += dppf<0x4E>(x); x += dppf<0x141>(x); x += dppf<0x140>(x); return x; }
DEVI float red32(float x) { x = red16(x); x += __shfl_xor(x, 16); return x; }
DEVI float red64(float x) { x = red16(x); x += __shfl_xor(x, 16); x += __shfl_xor(x, 32); return x; }
DEVI void cpow(float are, float aim, float dt, float tau, float& re, float& im) {
  float mag = expf(tau * are * dt);
  float th = tau * aim * dt;
  float n = rintf(th * 0.15915494309189535f);
  float r = fmaf(-n, 6.28125f, th);
  r = fmaf(-n, 1.9353071795864769e-3f, r);
  re = mag * cosf(r); im = mag * sinf(r);
}

constexpr int BM = 256, BK = 64, HALF = 128, HT = HALF * BK;
DEVI int lds_byte(int r, int c) {
  int st = (r >> 4) * 2 + (c >> 5), rr = r & 15, cc = c & 31, ob = rr * 64 + cc * 2;
  return st * 1024 + (ob ^ (((ob >> 9) & 1) << 5));
}
DEVI void stage_rc(int b, int& R, int& C) {
  int st = b / 1024, sb = b % 1024, swz = sb ^ (((sb >> 9) & 1) << 5);
  R = (st >> 1) * 16 + swz / 64; C = (st & 1) * 32 + (swz % 64) / 2;
}

DEVI void gemm_core(const int wv_in, u16* shm, const u16* A, long lda, const u16* Bt, long ldb, int K, int brow, int bcol, f32x4 (&acc)[2][2][4][2]) {
#define SA(b, h) (shm + ((b) * 2 + (h)) * HT)
#define SB(b, h) (shm + (4 + (b) * 2 + (h)) * HT)
#define STAGE(P, BASE, LD, OFFS, br, kt) do { const char* _ub = (const char*)((BASE) + (long)(br) * (LD) + (long)(kt) * BK); \
    _Pragma("unroll") for (int _i = 0; _i < 2; ++_i) { \
      __builtin_amdgcn_global_load_lds((const unsigned*)(_ub + OFFS[_i]), \
        (__attribute__((address_space(3))) unsigned*)((char*)(P) + wv_s * 1024 + _i * 8192), 16, 0, 0); } } while (0)
#define LDA(dst, b, h) _Pragma("unroll") for (int m = 0; m < 4; ++m) _Pragma("unroll") for (int k = 0; k < 2; ++k) \
    dst[m][k] = *reinterpret_cast<const bf16x8*>((char*)SA(b, h) + lds_byte(wr * 64 + m * 16 + fr, k * 32 + fq * 8))
#define LDB(dst, b, h) _Pragma("unroll") for (int n = 0; n < 2; ++n) _Pragma("unroll") for (int k = 0; k < 2; ++k) \
    dst[n][k] = *reinterpret_cast<const bf16x8*>((char*)SB(b, h) + lds_byte(wc * 32 + n * 16 + fr, k * 32 + fq * 8))
#define MMA(ai, bj, At, Bq) do { __builtin_amdgcn_s_setprio(1); \
    _Pragma("unroll") for (int m = 0; m < 4; ++m) _Pragma("unroll") for (int n = 0; n < 2; ++n) _Pragma("unroll") for (int k = 0; k < 2; ++k) \
      acc[ai][bj][m][n] = __builtin_amdgcn_mfma_f32_16x16x32_bf16(At[m][k], Bq[n][k], acc[ai][bj][m][n], 0, 0, 0); \
    __builtin_amdgcn_s_setprio(0); } while (0)
#define WAIT_V(n) asm volatile("s_waitcnt vmcnt(" #n ")" ::: "memory")
#define WAIT_L(n) asm volatile("s_waitcnt lgkmcnt(" #n ")" ::: "memory")
#define BAR __builtin_amdgcn_s_barrier()
#define SCHED __builtin_amdgcn_sched_barrier(0)
  const int tid = wv_in * 64 + lane_id_opaque();
  const int wv_s = wv_in;
  const int wid = tid >> 6, lane = tid & 63, wr = wid >> 2, wc = wid & 3, fr = lane & 15, fq = lane >> 4;
#pragma unroll
  for (int a = 0; a < 2; ++a)
#pragma unroll
    for (int b = 0; b < 2; ++b)
#pragma unroll
      for (int m = 0; m < 4; ++m)
#pragma unroll
        for (int n = 0; n < 2; ++n) acc[a][b][m][n] = (f32x4){0.f, 0.f, 0.f, 0.f};
  bf16x8 At[4][2], B0[2][2], B1[2][2];
  const int nt = K / BK;
  unsigned offA[2], offB[2];
#pragma unroll
  for (int i = 0; i < 2; ++i) { int r_, c_; stage_rc(tid * 16 + i * 8192, r_, c_); offA[i] = (unsigned)(r_ * (int)lda + c_) * 2u; offB[i] = (unsigned)(r_ * (int)ldb + c_) * 2u; }
  WAIT_V(0);
  STAGE(SB(0, 0), Bt, ldb, offB, bcol, 0); STAGE(SA(0, 0), A, lda, offA, brow, 0);
  STAGE(SB(0, 1), Bt, ldb, offB, bcol + HALF, 0); STAGE(SA(0, 1), A, lda, offA, brow + HALF, 0);
  if (wr == 1) BAR;
  WAIT_V(4); BAR;
  STAGE(SB(1, 0), Bt, ldb, offB, bcol, 1); STAGE(SA(1, 0), A, lda, offA, brow, 1); STAGE(SB(1, 1), Bt, ldb, offB, bcol + HALF, 1);
  WAIT_V(6); BAR;
  for (int t = 0; t < nt - 2; t += 2) {
    LDB(B0, 0, 0); SCHED; LDA(At, 0, 0); STAGE(SA(1, 1), A, lda, offA, brow + HALF, t + 1);
    WAIT_L(8); BAR; WAIT_L(0); MMA(0, 0, At, B0); BAR; SCHED;
    LDB(B1, 0, 1); STAGE(SB(0, 0), Bt, ldb, offB, bcol, t + 2);
    BAR; WAIT_L(0); MMA(0, 1, At, B1); BAR;
    LDA(At, 0, 1); STAGE(SA(0, 0), A, lda, offA, brow, t + 2);
    BAR; WAIT_L(0); MMA(1, 0, At, B0); BAR; SCHED;
    STAGE(SB(0, 1), Bt, ldb, offB, bcol + HALF, t + 2);
    WAIT_V(6); BAR; MMA(1, 1, At, B1); BAR;
    LDB(B0, 1, 0); SCHED; LDA(At, 1, 0); STAGE(SA(0, 1), A, lda, offA, brow + HALF, t + 2);
    WAIT_L(8); BAR; WAIT_L(0); MMA(0, 0, At, B0); BAR; SCHED;
    LDB(B1, 1, 1); STAGE(SB(1, 0), Bt, ldb, offB, bcol, t + 3);
    BAR; WAIT_L(0); MMA(0, 1, At, B1); BAR;
    LDA(At, 1, 1); STAGE(SA(1, 0), A, lda, offA, brow, t + 3);
    BAR; WAIT_L(0); MMA(1, 0, At, B0); BAR; SCHED;
    STAGE(SB(1, 1), Bt, ldb, offB, bcol + HALF, t + 3);
    WAIT_V(6); BAR; MMA(1, 1, At, B1); BAR;
  }
  { LDB(B0, 0, 0); LDA(At, 0, 0); STAGE(SA(1, 1), A, lda, offA, brow + HALF, nt - 1);
    BAR; WAIT_L(0); MMA(0, 0, At, B0); BAR;
    LDB(B1, 0, 1); BAR; WAIT_L(0); MMA(0, 1, At, B1); BAR;
    LDA(At, 0, 1); WAIT_V(4); BAR; WAIT_L(0); MMA(1, 0, At, B0); MMA(1, 1, At, B1); BAR; }
  { LDB(B0, 1, 0); LDA(At, 1, 0); WAIT_V(2); BAR; WAIT_L(0); MMA(0, 0, At, B0); BAR;
    LDB(B1, 1, 1); WAIT_V(0); BAR; WAIT_L(0); MMA(0, 1, At, B1); BAR;
    LDA(At, 1, 1); BAR; WAIT_L(0); MMA(1, 0, At, B0); MMA(1, 1, At, B1); BAR; }
  if (wr == 0) BAR;
}

DEVI void tile_map(int nM, int nN, int idx, int& pm, int& pn) {
  int nwg = nM * nN; int q = nwg / 8, r = nwg % 8, xcd = idx % 8, off = idx / 8;
  int w = (xcd < r ? xcd * (q + 1) : r * (q + 1) + (xcd - r) * q) + off;
  int nig = 8 * nN, gid = w / nig, fm = gid * 8, gsz = min(nM - fm, 8);
  pm = fm + ((w % nig) % gsz); pn = (w % nig) / gsz;
}

struct ConvJob { const float* src; long ld; u16* dst; long ldd; int zero; };
DEVI void conv_load(const int tid, const ConvJob& j, float4 (&v)[4]) {
  const int rr2 = tid >> 4, cc = (tid & 15) * 4;
  const float* s0 = j.src + (long)(2 * rr2) * j.ld + cc;
  v[0] = ldnt4(s0); v[1] = ldnt4(s0 + j.ld);
  v[2] = ldnt4(s0 + 64); v[3] = ldnt4(s0 + j.ld + 64);
}
DEVI unsigned pk2(float a, float b) { return (unsigned)f2bf(a) | ((unsigned)f2bf(b) << 16); }
DEVI void conv_store(const int tid, unsigned char* smem, const ConvJob& j, const float4 (&v)[4]) {
  unsigned* T = (unsigned*)smem;
  const int rr2 = tid >> 4, cc = (tid & 15) * 4;
  const unsigned zm = j.zero ? 0u : 0xffffffffu;
#define pk2(a, b) (pk2(a, b) & zm)
  T[(cc + 0) * 36 + rr2] = pk2(v[0].x, v[1].x); T[(cc + 1) * 36 + rr2] = pk2(v[0].y, v[1].y);
  T[(cc + 2) * 36 + rr2] = pk2(v[0].z, v[1].z); T[(cc + 3) * 36 + rr2] = pk2(v[0].w, v[1].w);
  T[(cc + 64) * 36 + rr2] = pk2(v[2].x, v[3].x); T[(cc + 65) * 36 + rr2] = pk2(v[2].y, v[3].y);
  T[(cc + 66) * 36 + rr2] = pk2(v[2].z, v[3].z); T[(cc + 67) * 36 + rr2] = pk2(v[2].w, v[3].w);
#undef pk2
  __syncthreads();
#pragma unroll
  for (int h = 0; h < 2; ++h) {
    int n = (tid >> 3) + h * 64, kc = (tid & 7) * 4;
    uint4 o = *(const uint4*)(T + n * 36 + kc);
    *(uint4*)(j.dst + (long)n * j.ldd + kc * 2) = o;
  }
  __syncthreads();
}
DEVI ConvJob conv_job0(KP p, int idx) {
  ConvJob j; j.zero = 0;
  if (idx < 2176) { int nt = idx % 68, kt = idx / 68, n0 = nt * 128; j.zero = (n0 >= 4480 && n0 < 4608); int c0 = n0 < 4480 ? n0 : (j.zero ? 0 : n0 - 128);
    j.src = p->in[I_WIN] + (long)(kt * 64) * 8576 + c0; j.ld = 8576; j.dst = (u16*)(p->ws + OFF_A) + (long)n0 * 2048 + kt * 64; j.ldd = 2048; }
  else { int q = idx - 2176; j.ld = 1024; j.ldd = 384;
    if (q < 32) { int sec = q >> 3, nt = q & 7, d = sec & 1;
      j.src = (sec < 2 ? p->in[I_W2] : p->in[I_A2]) + (long)d * 64 * 1024 + nt * 128; j.dst = (u16*)(p->ws + OFF_LORAT) + (long)(sec * 1024 + nt * 128) * 384 + sec * 64; }
    else { int qq = q - 32, kt = qq >> 3, nt = qq & 7;
      j.src = p->in[I_G2] + (long)(kt * 64) * 1024 + nt * 128; j.dst = (u16*)(p->ws + OFF_LORAT) + (long)(4096 + nt * 128) * 384 + 256 + kt * 64; } }
  return j;
}
DEVI ConvJob conv_job7(KP p, int idx) {
  ConvJob j; j.zero = 0;
  { int kt = idx & 31, nt = (idx >> 5) + 2 * W13A_TILES, n0 = nt * 128, t = n0 >> 8, wi = n0 & 255; int c0 = wi < 128 ? t * 128 : DFF + t * 128;
    j.src = p->in[I_W13] + (long)(kt * 64) * (2 * DFF) + c0; j.ld = 2 * DFF; j.dst = (u16*)(p->ws + OFF_FX) + (long)n0 * 2048 + kt * 64; j.ldd = 2048; }
  return j;
}
DEVI ConvJob conv_job2(KP p, int idx) {
  ConvJob j; j.zero = 0;
  { int kt = idx % 88, nt = idx / 88, n0 = nt * 128;
    j.src = p->in[I_FW2] + (long)(kt * 64) * 2048 + n0; j.ld = 2048; j.dst = (u16*)(p->ws + OFF_W2T) + (long)n0 * DFF + kt * 64; j.ldd = DFF; }
  return j;
}
template <int WHICH>
DEVI void conv_run(KP p, const int tid, unsigned char* smem, int bid, int G) {
  const int njobs = WHICH == 0 ? 2224 : (WHICH == 1 ? (88 - 2 * W13A_TILES) * 32 : 1408);
  int idx = bid;
  if (idx >= njobs) return;
#define CJOB(i) (WHICH == 0 ? conv_job0(p, (i)) : (WHICH == 1 ? conv_job7(p, (i)) : conv_job2(p, (i))))
  ConvJob ja = CJOB(idx); float4 va[4]; conv_load(tid, ja, va);
  for (;;) {
    const int i1 = idx + G; const bool h1 = i1 < njobs;
    float4 vb[4];
    const ConvJob jb = CJOB(h1 ? i1 : idx); conv_load(tid, jb, vb);
    conv_store(tid, smem, ja, va);
    if (!h1) break;
    const int i2 = i1 + G; const bool h2 = i2 < njobs;
    ja = CJOB(h2 ? i2 : i1); conv_load(tid, ja, va);
    conv_store(tid, smem, jb, vb);
    if (!h2) break;
    idx = i2;
  }
#undef CJOB
}

DEVI void row_norm_phase(KP p, const int tid, int mode, int bid, int G) {
  const int lane = tid & 63, wave = tid >> 6;
  const float* MOD = (const float*)(p->ws + OFF_MOD);
  const float* adab = p->in[I_ADAB];
  const int nrows = (mode == 0) ? NTOK : NLAT;
  for (int r = bid * 8 + wave; r < nrows; r += G * 8) {
    const float* src; int mrow;
    if (mode == 0) { if (r < NLAT) { src = p->in[I_X] + (size_t)r * 2048; mrow = r >> 12; } else { src = p->in[I_CTX] + (size_t)(r - NLAT) * 2048; mrow = 2; } }
    else { src = p->out + (size_t)r * 2048; mrow = r >> 12; }
    float4 v[8]; float ss = 0.f;
#pragma unroll
    for (int i = 0; i < 8; ++i) { v[i] = ldnt4(src + (i * 64 + lane) * 4); ss += v[i].x * v[i].x + v[i].y * v[i].y + v[i].z * v[i].z + v[i].w * v[i].w; }
    ss = red64(ss);
    const float rs = rsqrtf(ss * (1.f / 2048.f) + 1e-6f);
    const float* nw = p->in[mode == 0 ? I_N1W : (mode == 1 ? I_N2W : I_NF)];
    const int shoff = (mode == 0) ? 0 : 6144, scoff = (mode == 0) ? 2048 : 8192;
    u16* dstb = (u16*)(p->ws + (mode == 0 ? OFF_B : OFF_A)) + (size_t)r * 2048;
#pragma unroll
    for (int i = 0; i < 8; ++i) {
      int c = (i * 64 + lane) * 4;
      float4 w4 = *(const float4*)(nw + c);
      float y0 = v[i].x * rs * w4.x, y1 = v[i].y * rs * w4.y, y2 = v[i].z * rs * w4.z, y3 = v[i].w * rs * w4.w;
      if (mode == 2) { f32x4 o4_ = {y0, y1, y2, y3}; __builtin_nontemporal_store(o4_, (f32x4*)(p->out + (size_t)r * 2048 + c)); }
      else {
        float4 sh = *(const float4*)(MOD + mrow * 12288 + shoff + c), shb = *(const float4*)(adab + shoff + c);
        float4 sc = *(const float4*)(MOD + mrow * 12288 + scoff + c), scb = *(const float4*)(adab + scoff + c);
        y0 = y0 * (1.f + sc.x + scb.x) + sh.x + shb.x; y1 = y1 * (1.f + sc.y + scb.y) + sh.y + shb.y;
        y2 = y2 * (1.f + sc.z + scb.z) + sh.z + shb.z; y3 = y3 * (1.f + sc.w + scb.w) + sh.w + shb.w;
        uint2 o; o.x = (unsigned)f2bf(y0) | ((unsigned)f2bf(y1) << 16); o.y = (unsigned)f2bf(y2) | ((unsigned)f2bf(y3) << 16);
        *(uint2*)(dstb + c) = o;
      }
    }
  }
}

DEVI void phase0(KP p, const int tid, unsigned char* smem, int bid, int G) {
  {
    float* sv = (float*)smem;
    float* red = (float*)(smem + 24576);
    for (int i = tid; i < 3 * 2048; i += NTHR) {
      int j = i >> 11, k = i & 2047;
      float cv = (j < 2) ? p->in[I_C][j * 2048 + k] : p->in[I_CCTX][k];
      sv[i] = silu_(cv);
    }
    __syncthreads();
    float* MOD = (float*)(p->ws + OFF_MOD);
    const float* aw = p->in[I_ADAW];
    for (int cb = bid; cb < 256; cb += G) {
      const int cgq = tid % 12, ksl = tid / 12;
      float a0[4] = {0, 0, 0, 0}, a1[4] = {0, 0, 0, 0}, a2[4] = {0, 0, 0, 0};
      if (tid < 504) {
        const float* wp = aw + cb * 48 + cgq * 4;
#pragma unroll 7
        for (int k = ksl; k < 2048; k += 42) {
          float4 wv = ldnt4(wp + (size_t)k * 12288);
          float s0 = sv[k], s1 = sv[2048 + k], s2 = sv[4096 + k];
          a0[0] += s0 * wv.x; a0[1] += s0 * wv.y; a0[2] += s0 * wv.z; a0[3] += s0 * wv.w;
          a1[0] += s1 * wv.x; a1[1] += s1 * wv.y; a1[2] += s1 * wv.z; a1[3] += s1 * wv.w;
          a2[0] += s2 * wv.x; a2[1] += s2 * wv.y; a2[2] += s2 * wv.z; a2[3] += s2 * wv.w;
        }
        float* rp = red + (ksl * 12 + cgq) * 12;
#pragma unroll
        for (int e = 0; e < 4; ++e) { rp[e] = a0[e]; rp[4 + e] = a1[e]; rp[8 + e] = a2[e]; }
      }
      __syncthreads();
      if (tid < 144) {
        const int j = tid / 48, c = tid % 48;
        float sum = 0.f;
        for (int q = 0; q < 42; ++q) sum += red[(q * 12 + (c >> 2)) * 12 + j * 4 + (c & 3)];
        MOD[j * 12288 + cb * 48 + c] = sum;
      }
      __syncthreads();
    }
  }
  for (int g = G - 1 - bid; g < 64 && g >= 0; g += G) {
    float2* lamp = (float2*)smem;
    float2* bb = (float2*)(smem + 17408);
    float2* cm = (float2*)(smem + 17408 + 16384);
    float* ktab = (float*)(smem + 17408 + 32768);
    for (int i = tid; i < 2 * 17 * 64; i += NTHR) {
      int d = i / (17 * 64), tau = (i / 64) % 17, pp = i & 63;
      float are = p->in[I_SARE][(d * 64 + g) * 64 + pp], aim = p->in[I_SAIM][(d * 64 + g) * 64 + pp];
      float dt = expf(p->in[I_SLDT][d * 64 + g]);
      float re, im; cpow(are, aim, dt, (float)tau, re, im);
      lamp[i] = make_float2(re, im);
    }
    for (int i = tid; i < 2048; i += NTHR) {
      int d = i >> 10, pp = (i >> 4) & 63, h = i & 15;
      float are = p->in[I_SARE][(d * 64 + g) * 64 + pp], aim = p->in[I_SAIM][(d * 64 + g) * 64 + pp];
      float dt = expf(p->in[I_SLDT][d * 64 + g]);
      float lr, li; cpow(are, aim, dt, 1.f, lr, li);
      float nr = lr - 1.f, ni = li, den = 1.f / (are * are + aim * aim);
      float qr = (nr * are + ni * aim) * den, qi = (ni * are - nr * aim) * den;
      float br = p->in[I_SBRE][((size_t)(d * 64 + g) * 64 + pp) * 16 + h], bi = p->in[I_SBIM][((size_t)(d * 64 + g) * 64 + pp) * 16 + h];
      bb[i] = make_float2(qr * br - qi * bi, qr * bi + qi * br);
      int h2 = (i >> 6) & 15, p2 = i & 63;
      cm[i] = make_float2(p->in[I_SCRE][((size_t)(d * 64 + g) * 16 + h2) * 64 + p2], p->in[I_SCIM][((size_t)(d * 64 + g) * 16 + h2) * 64 + p2]);
    }
    __syncthreads();
    {
      const int d = tid >> 8, h = (tid >> 4) & 15, h2 = tid & 15;
      float acc[16];
#pragma unroll
      for (int tau = 0; tau < 16; ++tau) acc[tau] = 0.f;
      for (int pp = 0; pp < 64; ++pp) {
        const float2 c = cm[(d * 16 + h) * 64 + pp], b = bb[(d * 64 + pp) * 16 + h2];
        const float zr = c.x * b.x - c.y * b.y, zi = c.x * b.y + c.y * b.x;
#pragma unroll
        for (int tau = 0; tau < 16; ++tau) { const float2 l = lamp[(d * 17 + tau) * 64 + pp]; acc[tau] += zr * l.x - zi * l.y; }
      }
#pragma unroll
      for (int tau = 0; tau < 16; ++tau) ktab[(d * 16 + tau) * 256 + h * 16 + h2] = acc[tau];
    }
    __syncthreads();
    u16* BM_ = (u16*)(p->ws + OFF_BMAT) + (size_t)g * 65536;
    for (int ch = tid; ch < 8192; ch += NTHR) {
      int n = ch >> 5, k8 = (ch & 31) * 8;
      int d = n >> 7, part = (n >> 6) & 1, pp = n & 63, j = k8 >> 4, h0 = k8 & 15;
      float2 l = lamp[(d * 17 + (d == 0 ? 15 - j : j)) * 64 + pp];
      unsigned o[4];
#pragma unroll
      for (int e = 0; e < 8; ++e) {
        float2 b = bb[(d * 64 + pp) * 16 + h0 + e];
        float val = part == 0 ? (l.x * b.x - l.y * b.y) : (l.x * b.y + l.y * b.x);
        if (e & 1) o[e >> 1] |= (unsigned)f2bf(val) << 16; else o[e >> 1] = f2bf(val);
      }
      *(uint4*)(BM_ + n * 256 + k8) = make_uint4(o[0], o[1], o[2], o[3]);
    }
    u16* KC_ = (u16*)(p->ws + OFF_KC) + (size_t)g * 131072;
    for (int ch = tid; ch < 16384; ch += NTHR) {
      int n = ch >> 6, k8 = (ch & 63) * 8;
      int i = n >> 4, h = n & 15;
      unsigned o[4];
#pragma unroll
      for (int e = 0; e < 8; ++e) {
        int k = k8 + e; float val;
        if (k < 256) {
          int j = k >> 4, h2 = k & 15;
          val = 0.f;
          if (j <= i) val += ktab[(0 * 16 + (i - j)) * 256 + h * 16 + h2];
          if (j >= i) val += ktab[(1 * 16 + (j - i)) * 256 + h * 16 + h2];
          if (j == i && h == h2) val += p->in[I_SD][g * 16 + h];
        } else {
          int kk = k - 256, d = kk >> 7, part = (kk >> 6) & 1, pp = kk & 63;
          int ex = d == 0 ? i + 1 : 16 - i;
          float2 c = cm[(d * 16 + h) * 64 + pp], l = lamp[(d * 17 + ex) * 64 + pp];
          val = part == 0 ? (c.x * l.x - c.y * l.y) : -(c.x * l.y + c.y * l.x);
        }
        if (e & 1) o[e >> 1] |= (unsigned)f2bf(val) << 16; else o[e >> 1] = f2bf(val);
      }
      *(uint4*)(KC_ + n * 512 + k8) = make_uint4(o[0], o[1], o[2], o[3]);
    }
    __syncthreads();
  }
  if (G > 128) { if (bid < G - 64) conv_run<0>(p, tid, smem, bid, G - 64); }
  else conv_run<0>(p, tid, smem, bid, G);
  {
    u16* LT = (u16*)(p->ws + OFF_LORAT);
    for (int ch = bid * NTHR + tid; ch < 5120 * 48; ch += G * NTHR) {
      int n = ch / 48, rem = ch % 48, kb = rem >> 3, part = rem & 7, sec = n >> 10;
      bool nz = (sec < 4) ? (kb == sec) : (kb >= 4);
      if (!nz) *(uint4*)(LT + (size_t)n * 384 + kb * 64 + part * 8) = make_uint4(0, 0, 0, 0);
    }
  }
}

DEVI float red8(float x) { x += dppf<0xB1>(x); x += dppf<0x4E>(x); x += dppf<0x141>(x); return x; }
DEVI void phase3_prep(KP p, const int tid, int bid, int G) {
  const int slot = tid >> 7, t = tid & 127;
  const h16* ZRW = (const h16*)(p->ws + OFF_D);
  h16* Rb = (h16*)(p->ws + OFF_A); h16* Kb = Rb + (size_t)NTOK * 1024;
  h16* Vb = (h16*)(p->ws + OFF_B); h16* KKb = Vb + (size_t)NTOK * 1024;
  u16* LA = (u16*)(p->ws + OFF_LA);
  const float* mu = p->in[I_MU];
  for (int r = bid * 4 + slot; r < NTOK; r += G * 4) {
    int ru, rd, rl, rr; float fu, fd, fl, frr;
    if (r < NLAT) { int l = r & 4095, gr = l >> 6, gc = l & 63;
      fu = gr > 0; fd = gr < 63; fl = gc > 0; frr = gc < 63;
      ru = gr > 0 ? r - 64 : r; rd = gr < 63 ? r + 64 : r; rl = gc > 0 ? r - 1 : r; rr = gc < 63 ? r + 1 : r; }
    else { int l = (r - NLAT) & 255; fu = l > 0; fd = l < 255; fl = 0.f; frr = 0.f; ru = l > 0 ? r - 1 : r; rd = l < 255 ? r + 1 : r; rl = r; rr = r; }
    const float inv = 1.f / (fu + fd + fl + frr);
    fu *= inv; fd *= inv; fl *= inv; frr *= inv;
#define ZS8(c, o) do { h16x8 z_ = *(const h16x8*)(ZRW + (size_t)r * ZRWP + (c)); h16x8 u_ = *(const h16x8*)(ZRW + (size_t)ru * ZRWP + (c)); \
      h16x8 d_ = *(const h16x8*)(ZRW + (size_t)rd * ZRWP + (c)); h16x8 l_ = *(const h16x8*)(ZRW + (size_t)rl * ZRWP + (c)); h16x8 r_ = *(const h16x8*)(ZRW + (size_t)rr * ZRWP + (c)); \
      float4 ma_ = *(const float4*)(mu + (c)), mb_ = *(const float4*)(mu + (c) + 4); \
      const float mm_[8] = {ma_.x, ma_.y, ma_.z, ma_.w, mb_.x, mb_.y, mb_.z, mb_.w}; \
      _Pragma("unroll") for (int e = 0; e < 8; ++e) { float z = (float)z_[e]; \
        float m = fu * (float)u_[e] + fd * (float)d_[e] + fl * (float)l_[e] + frr * (float)r_[e]; o[e] = z + (m - z) * mm_[e]; } } while (0)
    float zr[8], zk[8], zv[8];
    ZS8(8 * t, zr); ZS8(1024 + 8 * t, zk); ZS8(2048 + 8 * t, zv);
    h16x8 o;
#pragma unroll
    for (int e = 0; e < 8; ++e) o[e] = (h16)zr[e];
    *(h16x8*)(Rb + (size_t)r * 1024 + 8 * t) = o;
#pragma unroll
    for (int e = 0; e < 8; ++e) o[e] = (h16)zk[e];
    *(h16x8*)(Kb + (size_t)r * 1024 + 8 * t) = o;
#pragma unroll
    for (int e = 0; e < 8; ++e) o[e] = (h16)zv[e];
    *(h16x8*)(Vb + (size_t)r * 1024 + 8 * t) = o;
    {
      float4 ka_ = *(const float4*)(p->in[I_KK] + 8 * t), kb_ = *(const float4*)(p->in[I_KK] + 8 * t + 4);
      const float kw[8] = {ka_.x, ka_.y, ka_.z, ka_.w, kb_.x, kb_.y, kb_.z, kb_.w};
      float kx[8]; float ss = 0.f;
#pragma unroll
      for (int e = 0; e < 8; ++e) { kx[e] = zk[e] * kw[e]; ss += kx[e] * kx[e]; }
      ss = red8(ss);
      const float rs = rsqrtf(ss + 1e-12f);
#pragma unroll
      for (int e = 0; e < 8; ++e) o[e] = (h16)(kx[e] * rs);
      *(h16x8*)(KKb + (size_t)r * 1024 + 8 * t) = o;
    }
    if (t < 48) {
      float zl[8];
      ZS8(3072 + 8 * t, zl);
      const int c = 8 * t;
      unsigned w[4];
#pragma unroll
      for (int e = 0; e < 8; e += 2) {
        float a = zl[e], b = zl[e + 1];
        if (c < 128) { a = tanh_(a); b = tanh_(b); } else if (c >= 256) { a = sigm(a); b = sigm(b); }
        w[e >> 1] = (unsigned)f2bf(a) | ((unsigned)f2bf(b) << 16);
      }
      *(uint4*)(LA + (size_t)r * 384 + c) = make_uint4(w[0], w[1], w[2], w[3]);
    }
#undef ZS8
  }
}

DEVI void phase4_chunkscan(KP p, const int tid, unsigned char* smem, int bid, int G) {
  const int pp = tid & 63, sl = tid >> 6;
  const float* XLOC = (const float*)p->out;
  u16* U2X = (u16*)(p->ws + OFF_C);
  float2* Fs = (float2*)smem;
  for (int combo = bid; combo < 256; combo += G) {
    const int b = combo >> 7, g = (combo >> 1) & 63, d = combo & 1;
    float are = p->in[I_SARE][(d * 64 + g) * 64 + pp], aim = p->in[I_SAIM][(d * 64 + g) * 64 + pp];
    float dt = expf(p->in[I_SLDT][d * 64 + g]);
    float mr, mi; cpow(are, aim, dt, 16.f, mr, mi);
    float xr[34], xi[34];
#pragma unroll
    for (int i = 0; i < 34; ++i) {
      int q = sl * 34 + i;
      int chunk = q < 16 ? 512 + b * 16 + (d ? 15 - q : q) : b * 256 + (d ? 255 - (q - 16) : (q - 16));
      const float* src = XLOC + ((size_t)g * 544 + chunk) * 256 + d * 128 + pp;
      xr[i] = src[0]; xi[i] = src[64];
    }
    float sr = 0.f, si = 0.f;
#pragma unroll
    for (int i = 0; i < 34; ++i) { float nr = mr * sr - mi * si + xr[i], ni = mr * si + mi * sr + xi[i]; sr = nr; si = ni; }
    Fs[sl * 64 + pp] = make_float2(sr, si);
    float m34r = 1.f, m34i = 0.f;
#pragma unroll
    for (int i = 0; i < 34; ++i) { float nr = m34r * mr - m34i * mi, ni = m34r * mi + m34i * mr; m34r = nr; m34i = ni; }
    __syncthreads();
    float cr = 0.f, ci = 0.f;
#pragma unroll
    for (int s2 = 0; s2 < 7; ++s2) {
      if (s2 < sl) { float2 f = Fs[s2 * 64 + pp]; float nr = m34r * cr - m34i * ci + f.x, ni = m34r * ci + m34i * cr + f.y; cr = nr; ci = ni; }
    }
    sr = cr; si = ci;
#pragma unroll
    for (int i = 0; i < 34; ++i) {
      int q = sl * 34 + i;
      if (q >= 16) {
        int chunk = b * 256 + (d ? 255 - (q - 16) : (q - 16));
        u16* dst = U2X + (size_t)g * GS + (size_t)chunk * 512 + 256 + d * 128 + pp;
        dst[0] = f2bf(sr); dst[64] = f2bf(si);
      }
      float nr = mr * sr - mi * si + xr[i], ni = mr * si + mi * sr + xi[i]; sr = nr; si = ni;
    }
    __syncthreads();
  }
}

struct CJ2 { const float* src; long ld; u16* dst; long ldd; };
DEVI CJ2 cjob_bg(KP p, int idx, int ng) {
  CJ2 j;
  if (idx < 512) { const int nt = idx & 15, kt = idx >> 4, wi = ng * 4; const int sc = wi < 128 ? nt * 128 + wi : 2048 + nt * 128 + wi - 128;
    j.src = p->in[I_GLUW] + (long)(kt * 32) * 4096 + sc; j.ld = 4096; j.dst = (u16*)(p->ws + OFF_GLUT) + (long)(nt * 256 + ng * 4) * 1024 + kt * 32; j.ldd = 1024; }
  else if (idx < 768) { const int q = idx - 512, nt = q & 7, kt = q >> 3;
    j.src = p->in[I_RWP] + (long)(kt * 32) * 2048 + nt * 256 + ng * 4; j.ld = 2048; j.dst = (u16*)(p->ws + OFF_RWPT) + (long)(nt * 256 + ng * 4) * 1024 + kt * 32; j.ldd = 1024; }
  else if (idx < 1280) { const int q = idx - 768, nt = q & 7, kt = q >> 3;
    j.src = p->in[I_WO] + (long)(kt * 32) * 2048 + nt * 256 + ng * 4; j.ld = 2048; j.dst = (u16*)(p->ws + OFF_WOT) + (long)(nt * 256 + ng * 4) * 2048 + kt * 32; j.ldd = 2048; }
  else { const int q = idx - 1280, nt = q % W13A_TILES, kt = q / W13A_TILES, wi = ng * 4; const int sc = wi < 128 ? nt * 128 + wi : DFF + nt * 128 + wi - 128;
    j.src = p->in[I_W13] + (long)(kt * 32) * (2 * DFF) + sc; j.ld = 2 * DFF; j.dst = (u16*)(p->ws + OFF_W13A) + (long)(nt * 256 + ng * 4) * 2048 + kt * 32; j.ldd = 2048; }
  return j;
}
DEVI void cj_load(const CJ2& j, int kg, float4 (&v)[8]) {
  const float* s0 = j.src + (long)(kg * 8) * j.ld;
#pragma unroll
  for (int i = 0; i < 8; ++i) v[i] = ldnt4(s0 + (long)i * j.ld);
}
DEVI void cj_store(const CJ2& j, int kg, const float4 (&v)[8]) {
  u16* d0 = j.dst + kg * 8;
  *(uint4*)(d0) = make_uint4(pk2(v[0].x, v[1].x), pk2(v[2].x, v[3].x), pk2(v[4].x, v[5].x), pk2(v[6].x, v[7].x));
  *(uint4*)(d0 + j.ldd) = make_uint4(pk2(v[0].y, v[1].y), pk2(v[2].y, v[3].y), pk2(v[4].y, v[5].y), pk2(v[6].y, v[7].y));
  *(uint4*)(d0 + 2 * j.ldd) = make_uint4(pk2(v[0].z, v[1].z), pk2(v[2].z, v[3].z), pk2(v[4].z, v[5].z), pk2(v[6].z, v[7].z));
  *(uint4*)(d0 + 3 * j.ldd) = make_uint4(pk2(v[0].w, v[1].w), pk2(v[2].w, v[3].w), pk2(v[4].w, v[5].w), pk2(v[6].w, v[7].w));
}

constexpr int TB = 32, STEPF = 336, BUFB = TB * STEPF * 4, YB_OFF = 2 * BUFB, YG = 16 * 68, YBB = (TB / 4) * YG * 4, NBLK = 4352 / TB;
constexpr int VT_OFF = YB_OFF + 2 * YBB, VTB = 16 * TB * 4;
typedef float f2 __attribute__((ext_vector_type(2)));
DEVI int tokrow(int s, int b, int d) { return s < 256 ? NLAT + b * 256 + (d ? 255 - s : s) : b * 4096 + (d ? 4095 - (s - 256) : (s - 256)); }

template <bool LAT>
DEVI void scan_block(const float* bp, const float* vt, float* yp, int ksl, int rowl, int lin, f2& sa, f2& sb) {
  float4 W[3], KA[3], KD[3], KK[3], R[3];
  float4 V4[8];
#pragma unroll
  for (int i = 0; i < 8; ++i) V4[i] = *(const float4*)(vt + rowl * TB + i * 4);
#define LDSTEP(i, t) do { const float* q_ = bp + (t) * STEPF + ksl * 4; W[i] = *(const float4*)(q_); KA[i] = *(const float4*)(q_ + 64); \
    KD[i] = *(const float4*)(q_ + 128); KK[i] = *(const float4*)(q_ + 192); if (LAT) R[i] = *(const float4*)(q_ + 256); } while (0)
  LDSTEP(0, 0); LDSTEP(1, 1);
  float yacc[4];
#pragma unroll
  for (int t = 0; t < TB; ++t) {
    if (t + 2 < TB) LDSTEP((t + 2) % 3, t + 2);
    const int i = t % 3;
    const f2 kk01 = {KK[i].x, KK[i].y}, kk23 = {KK[i].z, KK[i].w};
    f2 pr = sa * kk01; pr = sb * kk23 + pr;
    const float v = V4[t >> 2][t & 3];
    const f2 vv = {v, v};
    const f2 kd01 = {KD[i].x, KD[i].y}, kd23 = {KD[i].z, KD[i].w}, w01 = {W[i].x, W[i].y}, w23 = {W[i].z, W[i].w};
    const f2 qa = sa * w01 + vv * kd01, qb = sb * w23 + vv * kd23;
    const float u = red16(pr.x + pr.y);
    const f2 uu = {u, u};
    const f2 ka01 = {KA[i].x, KA[i].y}, ka23 = {KA[i].z, KA[i].w};
    sa = qa - uu * ka01; sb = qb - uu * ka23;
    if (LAT) {
      const f2 r01 = {R[i].x, R[i].y}, r23 = {R[i].z, R[i].w};
      f2 y = sa * r01; y = sb * r23 + y;
      yacc[t & 3] = y.x + y.y;
      if ((t & 3) == 3) *(float4*)(yp + (t >> 2) * YG + lin * 4 + (lin >> 4) * 4) = make_float4(yacc[0], yacc[1], yacc[2], yacc[3]);
    }
  }
#undef LDSTEP
}

DEVI void phase5_scan(KP p, const int tid, unsigned char* smem, int bid, int G) {
  for (int unit = bid; unit < 256; unit += G) {
    const int chain = unit >> 2, quarter = unit & 3, b = chain >> 5, head = (chain >> 1) & 15, d = chain & 1;
    const h16* Rb = (const h16*)(p->ws + OFF_A); const h16* Kb = Rb + (size_t)NTOK * 1024;
    const h16* Vb = (const h16*)(p->ws + OFF_B); const h16* KKb = Vb + (size_t)NTOK * 1024;
    const h16* EWb = (const h16*)(p->ws + OFF_FX) + (size_t)d * NTOK * 1024;
    const h16* Ab = (const h16*)(p->ws + OFF_FX) + (size_t)(2 + d) * NTOK * 1024;
    h16* Yd = (h16*)(p->ws + OFF_D) + (size_t)d * NLAT * 1024;
    const bool loader = tid >= 256;
    const int lt = tid - 256, lst = (lt >> 3) & 31, cg8 = lt & 7;
    const int lane = tid & 63, rowl = ((tid >> 6) & 3) * 4 + (lane >> 4), ksl = lane & 15, lin = tid & 255;
    f2 sa = {0.f, 0.f}, sb = {0.f, 0.f};
    float ka[8];
    float4 cv[8];
    const bool bgfirst = (unit == bid);
    constexpr int NBG = 1280 + W13A_TILES * 64;
    const int bg_nsl = (NBG + G - 1) / G;
    h16x8 rR, rK, rKK, rEW, rA; h16x2 rV;
#define LOADRAW(jb) do { int tok_ = tokrow((jb) * TB + lst, b, d); size_t base_ = (size_t)tok_ * 1024 + head * 64 + cg8 * 8; \
      rR = *(const h16x8*)(Rb + base_); rK = *(const h16x8*)(Kb + base_); rKK = *(const h16x8*)(KKb + base_); \
      rEW = *(const h16x8*)(EWb + base_); rA = *(const h16x8*)(Ab + base_); \
      rV = *(const h16x2*)(Vb + (size_t)tok_ * 1024 + head * 64 + quarter * 16 + cg8 * 2); } while (0)
#define CONVERT(bufi) do { float* dst_ = (float*)(smem + (bufi) * BUFB) + lst * STEPF; \
      float fw[8], fkka[8], fkd[8], fkk[8], frv[8]; \
      _Pragma("unroll") for (int e = 0; e < 8; ++e) { float a_ = (float)rA[e], kk_ = (float)rKK[e]; \
        fw[e] = __expf(-(float)rEW[e]); fkka[e] = kk_ * a_; fkd[e] = (float)rK[e] * (1.f + (a_ - 1.f) * ka[e]); fkk[e] = kk_; frv[e] = (float)rR[e]; } \
      *(float4*)(dst_ + cg8 * 8) = make_float4(fw[0], fw[1], fw[2], fw[3]); *(float4*)(dst_ + cg8 * 8 + 4) = make_float4(fw[4], fw[5], fw[6], fw[7]); \
      *(float4*)(dst_ + 64 + cg8 * 8) = make_float4(fkka[0], fkka[1], fkka[2], fkka[3]); *(float4*)(dst_ + 64 + cg8 * 8 + 4) = make_float4(fkka[4], fkka[5], fkka[6], fkka[7]); \
      *(float4*)(dst_ + 128 + cg8 * 8) = make_float4(fkd[0], fkd[1], fkd[2], fkd[3]); *(float4*)(dst_ + 128 + cg8 * 8 + 4) = make_float4(fkd[4], fkd[5], fkd[6], fkd[7]); \
      *(float4*)(dst_ + 192 + cg8 * 8) = make_float4(fkk[0], fkk[1], fkk[2], fkk[3]); *(float4*)(dst_ + 192 + cg8 * 8 + 4) = make_float4(fkk[4], fkk[5], fkk[6], fkk[7]); \
      *(float4*)(dst_ + 256 + cg8 * 8) = make_float4(frv[0], frv[1], frv[2], frv[3]); *(float4*)(dst_ + 256 + cg8 * 8 + 4) = make_float4(frv[4], frv[5], frv[6], frv[7]); \
      { float* vt_ = (float*)(smem + VT_OFF + (bufi) * VTB); vt_[(cg8 * 2) * TB + lst] = (float)rV[0]; vt_[(cg8 * 2 + 1) * TB + lst] = (float)rV[1]; } } while (0)
#define FLUSHY(jb) do { if (lt < 128) { const int t4_ = lt >> 4, row_ = lt & 15; \
      const float* yb_ = (const float*)(smem + YB_OFF + ((jb) & 1) * YBB) + t4_ * YG + row_ * 68; \
      float4 acc_ = *(const float4*)(yb_); \
      _Pragma("unroll") for (int l_ = 1; l_ < 16; ++l_) { const float4 q_ = *(const float4*)(yb_ + l_ * 4); acc_.x += q_.x; acc_.y += q_.y; acc_.z += q_.z; acc_.w += q_.w; } \
      const float ys_[4] = {acc_.x, acc_.y, acc_.z, acc_.w}; \
      _Pragma("unroll") for (int e_ = 0; e_ < 4; ++e_) { const int tok_ = tokrow((jb) * TB + t4_ * 4 + e_, b, d); \
        Yd[(size_t)tok_ * 1024 + head * 64 + quarter * 16 + row_] = (h16)ys_[e_]; } } } while (0)
    if (loader) {
#pragma unroll
      for (int e = 0; e < 8; ++e) ka[e] = p->in[I_KA][head * 64 + cg8 * 8 + e];
      LOADRAW(0); CONVERT(0); LOADRAW(1);
    }
    __syncthreads();
    for (int jb = 0; jb < NBLK; ++jb) {
      if (!loader) {
        const float* bp = (const float*)(smem + (jb & 1) * BUFB);
        float* yp = (float*)(smem + YB_OFF + (jb & 1) * YBB);
        const float* vt = (const float*)(smem + VT_OFF + (jb & 1) * VTB);
        if (jb < 8) scan_block<false>(bp, vt, yp, ksl, rowl, lin, sa, sb);
        else scan_block<true>(bp, vt, yp, ksl, rowl, lin, sa, sb);
      } else {
        if (jb + 1 < NBLK) CONVERT((jb + 1) & 1);
        if (jb + 2 < NBLK) LOADRAW(jb + 2);
        if (jb - 1 >= 8) FLUSHY(jb - 1);
        if (bgfirst && jb >= 10 && jb < 10 + 10 * bg_nsl && bid + G * ((jb - 10) / 10) < NBG) {
          const int ph20 = (jb - 10) % 10, sj = (jb - 10) / 10;
          if (ph20 == 0) { const CJ2 cj = cjob_bg(p, bid + G * sj, lt & 63); cj_load(cj, lt >> 6, cv); }
          else if (ph20 == 1) { const CJ2 cj = cjob_bg(p, bid + G * sj, lt & 63); cj_store(cj, lt >> 6, cv); }
        }
      }
      __syncthreads();
    }
    if (loader) FLUSHY(NBLK - 1);
    __syncthreads();
#undef LOADRAW
#undef CONVERT
#undef FLUSHY
  }
}

DEVI void phase6_post(KP p, const int tid, int bid, int G) {
  const int t = tid;
  const h16* Rb = (const h16*)(p->ws + OFF_A); const h16* Kb = Rb + (size_t)NTOK * 1024;
  const h16* Vb = (const h16*)(p->ws + OFF_B);
  const h16* A0b = (const h16*)(p->ws + OFF_FX) + (size_t)2 * NTOK * 1024; const h16* A1b = A0b + (size_t)NTOK * 1024; const h16* Gb = A1b + (size_t)NTOK * 1024;
  const h16* Y0 = (const h16*)(p->ws + OFF_D); const h16* Y1 = Y0 + (size_t)NLAT * 1024;
  u16* YRW = (u16*)(p->ws + OFF_C);
  const float2 kav = *(const float2*)(p->in[I_KA] + 2 * t), rkv = *(const float2*)(p->in[I_RK] + 2 * t);
  const float2 lw = *(const float2*)(p->in[I_LNW] + 2 * t), lb = *(const float2*)(p->in[I_LNB] + 2 * t);
  for (int r = bid; r < NLAT; r += G) {
    size_t o = (size_t)r * 1024 + 2 * t;
    h16x2 y0 = *(const h16x2*)(Y0 + o), y1 = *(const h16x2*)(Y1 + o);
    float ya = (float)y0[0] + (float)y1[0], yb = (float)y0[1] + (float)y1[1];
    float mean = red32(ya + yb) * (1.f / 64.f);
    float da = ya - mean, db = yb - mean;
    float var = red32(da * da + db * db) * (1.f / 64.f);
    float rs = rsqrtf(var + 64e-5f);
    h16x2 r2 = *(const h16x2*)(Rb + o), k2 = *(const h16x2*)(Kb + o), v2 = *(const h16x2*)(Vb + o);
    h16x2 a0 = *(const h16x2*)(A0b + o), a1 = *(const h16x2*)(A1b + o), g2 = *(const h16x2*)(Gb + o);
    float ra = (float)r2[0], rb = (float)r2[1], ka_ = (float)k2[0], kb_ = (float)k2[1];
    float kd0a = ka_ * (1.f + ((float)a0[0] - 1.f) * kav.x), kd0b = kb_ * (1.f + ((float)a0[1] - 1.f) * kav.y);
    float kd1a = ka_ * (1.f + ((float)a1[0] - 1.f) * kav.x), kd1b = kb_ * (1.f + ((float)a1[1] - 1.f) * kav.y);
    float bs = red32(ra * (kd0a + kd1a) * rkv.x + rb * (kd0b + kd1b) * rkv.y);
    float oa = (da * rs * lw.x + lb.x + bs * (float)v2[0]) * (float)g2[0];
    float ob = (db * rs * lw.y + lb.y + bs * (float)v2[1]) * (float)g2[1];
    *(unsigned*)(YRW + o) = (unsigned)f2bf(oa) | ((unsigned)f2bf(ob) << 16);
  }
}

DEVI void phase7_conv(KP p, const int tid, unsigned char* smem, int bid, int G) { conv_run<1>(p, tid, smem, bid, G); }

#define XB_XCNT(j) (64 * (j))
#define XB_XSUB(j) (1024 + 64 * (j))
#define XB_XGEN(j) (2048 + 64 * (j))
#define XB_TOP 3072
#define XB_TOPGEN 3136
DEVI unsigned xb_ld(unsigned* q) { return __hip_atomic_load(q, __ATOMIC_RELAXED, __HIP_MEMORY_SCOPE_AGENT); }
DEVI unsigned xb_add(unsigned* q, unsigned v) { return __hip_atomic_fetch_add(q, v, __ATOMIC_RELAXED, __HIP_MEMORY_SCOPE_AGENT); }
DEVI unsigned xb_xcc_id() { return (unsigned)__builtin_amdgcn_s_getreg((3 << 11) | 20) & 0xFu; }
DEVI void grid_barrier(unsigned* bar, const unsigned x, const unsigned nloc, const unsigned nx, const int tid) {
  asm volatile("s_waitcnt vmcnt(0) lgkmcnt(0)" ::: "memory");
  __syncthreads();
  if (tid == 0) {
    const unsigned old = xb_add(&bar[XB_XSUB(x)], 1u);
    const unsigned gen = old / nloc;
    if (old + 1u == (gen + 1u) * nloc) {
      __builtin_amdgcn_fence(__ATOMIC_RELEASE, "agent");
      asm volatile("s_waitcnt vmcnt(0)" ::: "memory");
      const unsigned og = xb_add(&bar[XB_TOP], 1u);
      const unsigned tg = og / nx;
      if (og + 1u == (tg + 1u) * nx) xb_add(&bar[XB_TOPGEN], 1u);
      else { while (xb_ld(&bar[XB_TOPGEN]) == tg) __builtin_amdgcn_s_sleep(1); }
      __builtin_amdgcn_fence(__ATOMIC_ACQUIRE, "agent");
      xb_add(&bar[XB_XGEN(x)], 1u);
      asm volatile("s_waitcnt vmcnt(0)" ::: "memory");
    } else {
      while (xb_ld(&bar[XB_XGEN(x)]) == gen) __builtin_amdgcn_s_sleep(1);
      __builtin_amdgcn_fence(__ATOMIC_ACQUIRE, "agent");
      asm volatile("s_waitcnt vmcnt(0)" ::: "memory");
    }
  }
  __syncthreads();
}

template <int ph>
DEVI void run_phase(KP p, const int wv, const int tid, const int bid, const int G, unsigned char* smem) {
  {
    switch (ph) {
      case 0: phase0(p, tid, smem, bid, G); break;
      case 1: row_norm_phase(p, tid, 0, bid, G); break;
      case 3: phase3_prep(p, tid, bid, G); break;
      case 4: phase4_chunkscan(p, tid, smem, bid, G); break;
      case 5: phase5_scan(p, tid, smem, bid, G); break;
      case 6: phase6_post(p, tid, bid, G); break;
      case 7: phase7_conv(p, tid, smem, bid, G); break;
      case 9: row_norm_phase(p, tid, 1, bid, G); break;
      case 12: row_norm_phase(p, tid, 2, bid, G); break;
      default: break;
    }
    int nunits = 0, nsub = 1;
    switch (ph) {
      case 2: nunits = 1124; break;
      case 3: nunits = 192; break;
      case 4: nunits = 680; break;
      case 5: nunits = 128; break;
      case 7: nunits = 256; nsub = 3; break;
      case 8: nunits = 256; break;
      case 10: nunits = 1408; break;
      case 11: nunits = 256; break;
      default: break;
    }
    if (nunits > 0) __syncthreads();
    for (int it0 = 0;; ++it0) {
      const int unit = bid + it0 * G;
      if (unit >= nunits) break;
#pragma unroll
     for (int sub = 0; sub < (ph == 7 ? 3 : 1); ++sub) {
      const u16* A = nullptr; const u16* Bt = nullptr; long lda = 0, ldb = 0; int K = 0, brow = 0, bcol = 0, pm = 0, pn = 0, e0 = 0;
      switch (ph) {
        case 2:
          if (unit < 1088) { tile_map(32, 34, unit, pm, pn); brow = pm * 256; } else { tile_map(2, 18, unit - 1088, pm, pn); brow = NLAT + pm * 256; }
          A = (const u16*)(p->ws + OFF_B); lda = 2048; Bt = (const u16*)(p->ws + OFF_A); ldb = 2048; K = 2048; bcol = pn * 256; break;
        case 3:
          e0 = unit / 3; pm = unit % 3; A = (const u16*)(p->ws + OFF_C) + (size_t)e0 * GS; lda = 512; brow = pm * 256;
          Bt = (const u16*)(p->ws + OFF_BMAT) + (size_t)e0 * 65536; ldb = 256; K = 256; bcol = 0; break;
        case 4:
          tile_map(34, 20, unit, pm, pn); { const int kwin = pn < 8 ? 0 : (pn < 16 ? 128 : 256);
          A = (const u16*)(p->ws + OFF_LA) + kwin; lda = 384; brow = pm * 256;
          Bt = (const u16*)(p->ws + OFF_LORAT) + kwin; ldb = 384; K = 128; bcol = pn * 256; } break;
        case 5:
          e0 = unit >> 1; pm = unit & 1; A = (const u16*)(p->ws + OFF_C) + (size_t)e0 * GS; lda = 512; brow = pm * 256;
          Bt = (const u16*)(p->ws + OFF_KC) + (size_t)e0 * 131072; ldb = 512; K = 512; bcol = 0; break;
        case 7:
          tile_map(32, 8, unit, pm, pn); brow = pm * 256; lda = 1024; ldb = 1024; K = 1024;
          if (sub < 2) { A = (const u16*)(p->ws + OFF_D + 33554432); Bt = (const u16*)(p->ws + OFF_GLUT); bcol = (pn * 2 + sub) * 256; }
          else { A = (const u16*)(p->ws + OFF_C); Bt = (const u16*)(p->ws + OFF_RWPT); bcol = pn * 256; }
          break;
        case 8:
          tile_map(32, 8, unit, pm, pn); A = (const u16*)(p->ws + OFF_B); lda = 2048; brow = pm * 256;
          Bt = (const u16*)(p->ws + OFF_WOT); ldb = 2048; K = 2048; bcol = pn * 256; break;
        case 10:
          tile_map(32, 44, unit, pm, pn); A = (const u16*)(p->ws + OFF_A); lda = 2048; brow = pm * 256;
          Bt = (const u16*)(p->ws + (pn < W13A_TILES ? OFF_W13A : OFF_FX)); ldb = 2048; K = 2048; bcol = pn * 256; break;
        default:
          tile_map(32, 8, unit, pm, pn); A = (const u16*)(p->ws + OFF_C); lda = DFF; brow = pm * 256;
          Bt = (const u16*)(p->ws + OFF_W2T); ldb = DFF; K = DFF; bcol = pn * 256; break;
      }
      f32x4 acc[2][2][4][2];
      gemm_core(wv, (u16*)smem, A, lda, Bt, ldb, K, brow, bcol, acc);
      const int te = wv * 64 + lane_id_opaque();
      const int wid = te >> 6, lane = te & 63, wr = wid >> 2, wc = wid & 3, fr = lane & 15, fq = lane >> 4;
#define QWRITE(Tp, ai, bj) _Pragma("unroll") for (int m = 0; m < 4; ++m) _Pragma("unroll") for (int n = 0; n < 2; ++n) _Pragma("unroll") for (int j = 0; j < 4; ++j) \
        (Tp)[(wr * 64 + m * 16 + fq * 4 + j) * 132 + wc * 32 + n * 16 + fr] = acc[ai][bj][m][n][j];
#define EPI_ALL(BODY) _Pragma("unroll") for (int ai = 0; ai < 2; ++ai) _Pragma("unroll") for (int bj = 0; bj < 2; ++bj) { __builtin_amdgcn_sched_barrier(0); \
      _Pragma("unroll") for (int m = 0; m < 4; ++m) _Pragma("unroll") for (int n = 0; n < 2; ++n) _Pragma("unroll") for (int j = 0; j < 4; ++j) { \
        const int row = brow + ai * 128 + wr * 64 + m * 16 + fq * 4 + j; const int col = bcol + bj * 128 + wc * 32 + n * 16 + fr; \
        const float v = acc[ai][bj][m][n][j]; BODY } }
#define EPI_HALF(BODY) _Pragma("unroll") for (int ai = 0; ai < 2; ++ai) { __builtin_amdgcn_sched_barrier(0); \
      _Pragma("unroll") for (int m = 0; m < 4; ++m) _Pragma("unroll") for (int n = 0; n < 2; ++n) _Pragma("unroll") for (int j = 0; j < 4; ++j) { \
        const int row = brow + ai * 128 + wr * 64 + m * 16 + fq * 4 + j; const int cw = wc * 32 + n * 16 + fr; \
        const float v0 = acc[ai][0][m][n][j]; const float v1 = acc[ai][1][m][n][j]; BODY } }
      switch (ph) {
        case 2: {
          if (pn < 4) { u16* U2X = (u16*)(p->ws + OFF_C);
            EPI_ALL({ U2X[(size_t)(col >> 4) * GS + (size_t)(row >> 4) * 512 + (row & 15) * 16 + (col & 15)] = f2bf(v); }) }
          else if (pn < 18) { h16* ZRW = (h16*)(p->ws + OFF_D);
            EPI_ALL({ ZRW[(size_t)row * ZRWP + (col - 1024)] = (h16)v; }) }
          else { u16* GT = (u16*)(p->ws + OFF_E);
            EPI_ALL({ GT[(size_t)row * 4096 + (col - 4608)] = f2bf(sigm(v)); }) }
        } break;
        case 3: { float* XLOC = p->out;
          EPI_ALL({ if (row < 544) XLOC[((size_t)e0 * 544 + row) * 256 + col] = v; }) } break;
        case 4: {
          const int sec = pn >> 2;
          h16* dst = (h16*)(p->ws + OFF_FX) + (size_t)sec * NTOK * 1024;
          if (sec < 2) { const float* w0 = p->in[I_W0] + sec * 1024;
            EPI_ALL({ const int c = col & 1023; dst[(size_t)row * 1024 + c] = (h16)(0.6065306597126334f * sigm(w0[c] + v)); }) }
          else if (sec < 4) { const float* a0 = p->in[I_A0] + (sec - 2) * 1024;
            EPI_ALL({ const int c = col & 1023; dst[(size_t)row * 1024 + c] = (h16)sigm(a0[c] + v); }) }
          else { EPI_ALL({ const int c = col & 1023; dst[(size_t)row * 1024 + c] = (h16)v; }) }
        } break;
        case 5: { u16* YS = (u16*)(p->ws + OFF_D + 33554432);
          EPI_ALL({ YS[(size_t)(row * 16 + (col >> 4)) * 1024 + e0 * 16 + (col & 15)] = f2bf(gelu_tanh(v)); }) } break;
        case 7: {
          const u16* GT = (const u16*)(p->ws + OFF_E); float* M1 = p->out;
          float* T0 = (float*)smem; float* T1 = (float*)smem + 128 * 132;
          const int c4 = te & 31, r0 = te >> 5;
          if (sub < 2) {
#pragma unroll
            for (int ai = 0; ai < 2; ++ai) {
              QWRITE(T0, ai, 0); QWRITE(T1, ai, 1);
              __syncthreads();
              const int cm_ = pn * 256 + sub * 128 + c4 * 4;
              uint2 gg[8];
#pragma unroll
              for (int i = 0; i < 8; ++i) gg[i] = *(const uint2*)(GT + (size_t)(brow + ai * 128 + r0 + i * 16) * 4096 + cm_);
#pragma unroll
              for (int i = 0; i < 8; ++i) {
                const int r = r0 + i * 16;
                const float4 a = *(const float4*)(T0 + r * 132 + c4 * 4), bq = *(const float4*)(T1 + r * 132 + c4 * 4);
                float4 o;
                o.x = a.x * sigm(bq.x) * bf2f((u16)(gg[i].x & 0xffffu)); o.y = a.y * sigm(bq.y) * bf2f((u16)(gg[i].x >> 16));
                o.z = a.z * sigm(bq.z) * bf2f((u16)(gg[i].y & 0xffffu)); o.w = a.w * sigm(bq.w) * bf2f((u16)(gg[i].y >> 16));
                *(float4*)(M1 + (size_t)(brow + ai * 128 + r) * 2048 + cm_) = o;
              }
              __syncthreads();
            }
          } else { u16* MG = (u16*)(p->ws + OFF_B);
#pragma unroll
            for (int ai = 0; ai < 2; ++ai)
#pragma unroll
              for (int bj = 0; bj < 2; ++bj) {
                QWRITE(T0, ai, bj);
                __syncthreads();
                const int col = bcol + bj * 128 + c4 * 4;
                uint2 gg[8]; float4 mm[8];
#pragma unroll
                for (int i = 0; i < 8; ++i) { const size_t row = (size_t)(brow + ai * 128 + r0 + i * 16);
                  gg[i] = *(const uint2*)(GT + row * 4096 + 2048 + col); mm[i] = *(const float4*)(M1 + row * 2048 + col); }
#pragma unroll
                for (int i = 0; i < 8; ++i) {
                  const int r = r0 + i * 16;
                  const float4 a = *(const float4*)(T0 + r * 132 + c4 * 4);
                  const float o0 = mm[i].x + bf2f((u16)(gg[i].x & 0xffffu)) * a.x, o1 = mm[i].y + bf2f((u16)(gg[i].x >> 16)) * a.y;
                  const float o2 = mm[i].z + bf2f((u16)(gg[i].y & 0xffffu)) * a.z, o3 = mm[i].w + bf2f((u16)(gg[i].y >> 16)) * a.w;
                  uint2 o; o.x = (unsigned)f2bf(o0) | ((unsigned)f2bf(o1) << 16); o.y = (unsigned)f2bf(o2) | ((unsigned)f2bf(o3) << 16);
                  *(uint2*)(MG + (size_t)(brow + ai * 128 + r) * 2048 + col) = o;
                }
                __syncthreads();
              }
          }
        } break;
        case 8: { const float* MOD = (const float*)(p->ws + OFF_MOD); const float* ab = p->in[I_ADAB]; const float* x = p->in[I_X];
          float* T0 = (float*)smem; const int c4 = te & 31, r0 = te >> 5;
#pragma unroll
          for (int ai = 0; ai < 2; ++ai)
#pragma unroll
            for (int bj = 0; bj < 2; ++bj) {
              QWRITE(T0, ai, bj);
              __syncthreads();
              const int col = bcol + bj * 128 + c4 * 4;
              const float4 ga = *(const float4*)(MOD + (brow >> 12) * 12288 + 4096 + col), gb = *(const float4*)(ab + 4096 + col);
              float4 xx[8];
#pragma unroll
              for (int i = 0; i < 8; ++i) xx[i] = *(const float4*)(x + (size_t)(brow + ai * 128 + r0 + i * 16) * 2048 + col);
#pragma unroll
              for (int i = 0; i < 8; ++i) {
                const int r = r0 + i * 16;
                const float4 a = *(const float4*)(T0 + r * 132 + c4 * 4);
                float4 o; o.x = xx[i].x + (ga.x + gb.x) * a.x; o.y = xx[i].y + (ga.y + gb.y) * a.y; o.z = xx[i].z + (ga.z + gb.z) * a.z; o.w = xx[i].w + (ga.w + gb.w) * a.w;
                *(float4*)(p->out + (size_t)(brow + ai * 128 + r) * 2048 + col) = o;
              }
              __syncthreads();
            }
        } break;
        case 10: { u16* ACT = (u16*)(p->ws + OFF_C);
          EPI_HALF({ ACT[(size_t)row * DFF + pn * 128 + cw] = f2bf(silu_(v0) * v1); }) } break;
        default: { const float* MOD = (const float*)(p->ws + OFF_MOD); const float* ab = p->in[I_ADAB];
          float* T0 = (float*)smem; const int c4 = te & 31, r0 = te >> 5;
#pragma unroll
          for (int ai = 0; ai < 2; ++ai)
#pragma unroll
            for (int bj = 0; bj < 2; ++bj) {
              QWRITE(T0, ai, bj);
              __syncthreads();
              const int col = bcol + bj * 128 + c4 * 4;
              const float4 ga = *(const float4*)(MOD + (brow >> 12) * 12288 + 10240 + col), gb = *(const float4*)(ab + 10240 + col);
              float4 xx[8];
#pragma unroll
              for (int i = 0; i < 8; ++i) xx[i] = *(const float4*)(p->out + (size_t)(brow + ai * 128 + r0 + i * 16) * 2048 + col);
#pragma unroll
              for (int i = 0; i < 8; ++i) {
                const int r = r0 + i * 16;
                const float4 a = *(const float4*)(T0 + r * 132 + c4 * 4);
                float4 o; o.x = xx[i].x + (ga.x + gb.x) * a.x; o.y = xx[i].y + (ga.y + gb.y) * a.y; o.z = xx[i].z + (ga.z + gb.z) * a.z; o.w = xx[i].w + (ga.w + gb.w) * a.w;
                *(float4*)(p->out + (size_t)(brow + ai * 128 + r) * 2048 + col) = o;
              }
              __syncthreads();
            }
        } break;
      }
     }
    }
    if (ph == 2 && G > 100 && bid >= 100) { __syncthreads(); conv_run<2>(p, wv * 64 + lane_id_opaque(), smem, bid - 100, G - 100); }
  }
}

__global__ void __launch_bounds__(NTHR, 2) mega(Params p_arg) {
  extern __shared__ __attribute__((aligned(16))) unsigned char smem[];
  const int G = gridDim.x;
  const int ph_lo = p_arg.ph_lo, ph_hi = p_arg.ph_hi;
  const int wv = __builtin_amdgcn_readfirstlane((int)threadIdx.x >> 6);
  const unsigned xcc = xb_xcc_id();
  unsigned nloc = 1u, nx = 1u;
  if (ph_hi > 1000) cg::this_grid().sync();
  if (ph_hi - ph_lo > 1) {
    unsigned* bar = (unsigned*)(p_arg.ws + OFF_XB);
    if (threadIdx.x == 0) (void)xb_add(&bar[XB_XCNT(xcc)], 1u);
  }
#define PHASE(k) if (ph_lo <= (k) && (k) < ph_hi) { \
    const int tid = wv * 64 + lane_id_opaque(); \
    int bid = blockIdx.x; asm volatile("" : "+s"(bid)); \
    KP p = (KP)__builtin_amdgcn_kernarg_segment_ptr(); asm volatile("" : "+s"(p)); \
    run_phase<k>(p, wv, tid, bid, G, smem); \
    if ((k) + 1 < ph_hi) { if ((k) == 0) {   \
        unsigned* bar = (unsigned*)(p->ws + OFF_XB); \
        if (wv * 64 + lane_id_opaque() == 0) { for (;;) { unsigned sum = 0u; _Pragma("unroll") for (unsigned j = 0; j < 16; ++j) sum += xb_ld(&bar[XB_XCNT(j)]); if (sum == (unsigned)G) break; __builtin_amdgcn_s_sleep(1); } } \
        __syncthreads(); \
        unsigned mine = 0u, cnt = 0u; \
        _Pragma("unroll") for (unsigned j = 0; j < 16; ++j) { const unsigned c = xb_ld(&bar[XB_XCNT(j)]); cnt += (c > 0u) ? 1u : 0u; mine = (j == xcc) ? c : mine; } \
        nloc = (unsigned)__builtin_amdgcn_readfirstlane((int)(mine > 0u ? mine : 1u)); nx = (unsigned)__builtin_amdgcn_readfirstlane((int)(cnt > 0u ? cnt : 1u)); } \
      grid_barrier((unsigned*)(p->ws + OFF_XB), xcc, nloc, nx, wv * 64 + lane_id_opaque()); } }
  PHASE(0) PHASE(1) PHASE(2) PHASE(3) PHASE(4) PHASE(5) PHASE(6) PHASE(7) PHASE(8) PHASE(9) PHASE(10) PHASE(11) PHASE(12)
}

extern "C" void kernel_launch(void* const* d_in, const int* in_sizes, int n_in, void* d_out, int out_size, void* d_ws, size_t ws_size,
                              hipStream_t stream) {
  constexpr int LDS_BYTES = 159744;
  static int grid = 0;
  if (grid == 0) {
    if (n_in != 34 || ws_size < WS_END) { fprintf(stderr, "kernel_launch: bad args n_in %d ws %zu (need %zu)\n", n_in, ws_size, (size_t)WS_END); grid = -1; return; }
    int dev = 0, cus = 0, per_cu = 0;
    hipGetDevice(&dev);
    hipDeviceGetAttribute(&cus, hipDeviceAttributeMultiprocessorCount, dev);
    if (hipFuncSetAttribute((const void*)mega, hipFuncAttributeMaxDynamicSharedMemorySize, LDS_BYTES) != hipSuccess) { fprintf(stderr, "hipFuncSetAttribute failed\n"); grid = -1; return; }
    hipOccupancyMaxActiveBlocksPerMultiprocessor(&per_cu, (const void*)mega, NTHR, LDS_BYTES);
    (void)hipGetLastError();
    if (per_cu < 1) per_cu = 1;
    grid = cus;
    fprintf(stderr, "kernel_launch: cus %d per_cu %d grid %d ws %zu\n", cus, per_cu, grid, ws_size);
  }
  if (grid < 0) return;
  hipMemsetAsync((char*)d_ws + OFF_XB, 0, 16384, stream);
  Params p{};
  for (int i = 0; i < 34; ++i) p.in[i] = (const float*)d_in[i];
  p.out = (float*)d_out; p.ws = (unsigned char*)d_ws;
#if ONE_LAUNCH
  p.ph_lo = 0; p.ph_hi = 13;
  void* args[] = {&p};
  hipError_t e = hipLaunchCooperativeKernel((const void*)mega, dim3(grid), dim3(NTHR), args, LDS_BYTES, stream);
  if (e != hipSuccess) fprintf(stderr, "cooperative launch failed: %s\n", hipGetErrorString(e));
#else
  for (int ph = 0; ph < 13; ++ph) {
    p.ph_lo = ph; p.ph_hi = ph + 1;
    hipLaunchKernelGGL(mega, dim3(grid), dim3(NTHR), LDS_BYTES, stream, p);
  }
#endif
}
```

```cpp
#include <hip/hip_runtime.h>
#include <hip/hip_cooperative_groups.h>
#include <cstdio>
namespace cg = cooperative_groups;

#ifndef ONE_LAUNCH
#define ONE_LAUNCH 1
#endif

typedef unsigned short u16;
typedef _Float16 h16;
using bf16x8 = __attribute__((ext_vector_type(8))) short;
using f32x4 = __attribute__((ext_vector_type(4))) float;
using h16x2 = __attribute__((ext_vector_type(2))) _Float16;
using h16x8 = __attribute__((ext_vector_type(8))) _Float16;
#define DEVI __device__ __forceinline__

constexpr int NLAT = 8192, NTOK = 8704;
constexpr int ZRWP = 3584;
constexpr int DFF = 5632;
constexpr int GS = 544 * 512;
constexpr int NTHR = 512;

constexpr size_t ARRB = 17825792;
constexpr size_t OFF_MOD = 0;
constexpr size_t OFF_BAR = 147456;
constexpr size_t OFF_GLUT = 147456 + 256;
constexpr size_t OFF_RWPT = OFF_GLUT + 8388608;
constexpr size_t OFF_WOT = OFF_RWPT + 4194304;
constexpr size_t OFF_LORAT = OFF_WOT + 8388608;
constexpr size_t OFF_BMAT = OFF_LORAT + 3932160;
constexpr size_t OFF_KC = OFF_BMAT + 8388608;
constexpr size_t OFF_LA = OFF_KC + 16777216;
constexpr size_t OFF_A = OFF_LA + 6684672;
constexpr size_t OFF_B = OFF_A + 35651584;
constexpr size_t OFF_FX = OFF_B + 35651584;
constexpr size_t OFF_C = OFF_FX + 89128960;
constexpr size_t OFF_D = OFF_C + 35880960;
constexpr size_t OFF_E = OFF_D + 62390272;
constexpr size_t OFF_XB = OFF_E + 67108864;
constexpr size_t OFF_W2T = OFF_XB + 16384;
constexpr size_t OFF_W13A = OFF_W2T + 23068672;
constexpr int W13A_TILES = 19;
constexpr size_t WS_END = OFF_W13A + (size_t)W13A_TILES * 256 * 2048 * 2;

constexpr size_t W13_TILE_B = (size_t)256 * 2048 * 2;
constexpr int W13_BG_TILES = 41;
__device__ __forceinline__ unsigned short* w13_tile_base(unsigned char* ws, int nt) {
  size_t off;
  if (nt < 19) off = OFF_W13A + (size_t)nt * W13_TILE_B;
  else if (nt < 24) off = OFF_D + 56393728 + (size_t)(nt - 19) * W13_TILE_B;
  else if (nt < 30) off = OFF_LA + (size_t)(nt - 24) * W13_TILE_B;
  else if (nt < 38) off = OFF_BMAT + (size_t)(nt - 30) * W13_TILE_B;
  else if (nt < 41) off = OFF_LORAT + (size_t)(nt - 38) * W13_TILE_B;
  else off = OFF_FX + (size_t)nt * W13_TILE_B;
  return (unsigned short*)(ws + off);
}

struct Params {
  const float* in[34];
  float* out;
  unsigned char* ws;
  int ph_lo, ph_hi;
};
typedef const __attribute__((address_space(4))) Params* KP;

enum { I_X = 0, I_C, I_CTX, I_CCTX, I_ADAW, I_ADAB, I_N1W, I_WIN, I_MU, I_SARE, I_SAIM, I_SLDT, I_SBRE, I_SBIM, I_SCRE, I_SCIM,
       I_SD, I_GLUW, I_W0, I_W2, I_A0, I_A2, I_G2, I_KK, I_KA, I_RK, I_LNW, I_LNB, I_RWP, I_WO, I_N2W, I_W13, I_FW2, I_NF };

DEVI float4 ldnt4(const float* q) { f32x4 v = __builtin_nontemporal_load((const f32x4*)q); return make_float4(v[0], v[1], v[2], v[3]); }
DEVI int lane_id_opaque() { int r; asm volatile("v_mbcnt_lo_u32_b32 %0, -1, 0\n\tv_mbcnt_hi_u32_b32 %0, -1, %0" : "=v"(r)); return r; }
DEVI u16 f2bf(float f) { unsigned u = __float_as_uint(f); u += 0x7fffu + ((u >> 16) & 1u); return (u16)(u >> 16); }
DEVI float bf2f(u16 h) { return __uint_as_float(((unsigned)h) << 16); }
DEVI float sigm(float x) { return 1.f / (1.f + __expf(-x)); }
DEVI float tanh_(float x) { float e = __expf(2.f * x); return 1.f - 2.f / (1.f + e); }
DEVI float gelu_tanh(float x) { float u = 0.7978845608028654f * (x + 0.044715f * x * x * x); return 0.5f * x * (1.f + tanh_(u)); }
DEVI float silu_(float x) { return x / (1.f + __expf(-x)); }
template <int CTRL> DEVI float dppf(float x) {
  return __builtin_bit_cast(float, __builtin_amdgcn_update_dpp(0, __builtin_bit_cast(int, x), CTRL, 0xF, 0xF, false));
}
DEVI float red16(float x) { x += dppf<0xB1>(x); x += dppf<0x4E>(x); x += dppf<0x141>(x); x += dppf<0x140>(x); return x; }
DEVI float red32(float x) { x = red16(x); x += __shfl_xor(x, 16); return x; }
DEVI float red64(float x) { x = red16(x); x += __shfl_xor(x, 16); x += __shfl_xor(x, 32); return x; }
DEVI void cpow(float are, float aim, float dt, float tau, float& re, float& im) {
  float mag = expf(tau * are * dt);
  float th = tau * aim * dt;
  float n = rintf(th * 0.15915494309189535f);
  float r = fmaf(-n, 6.28125f, th);
  r = fmaf(-n, 1.9353071795864769e-3f, r);
  re = mag * cosf(r); im = mag * sinf(r);
}

constexpr int BM = 256, BK = 64, HALF = 128, HT = HALF * BK;
DEVI int lds_byte(int r, int c) {
  int st = (r >> 4) * 2 + (c >> 5), rr = r & 15, cc = c & 31, ob = rr * 64 + cc * 2;
  return st * 1024 + (ob ^ (((ob >> 9) & 1) << 5));
}
DEVI void stage_rc(int b, int& R, int& C) {
  int st = b / 1024, sb = b % 1024, swz = sb ^ (((sb >> 9) & 1) << 5);
  R = (st >> 1) * 16 + swz / 64; C = (st & 1) * 32 + (swz % 64) / 2;
}

DEVI void gemm_core(const int wv_in, u16* shm, const u16* A, long lda, const u16* Bt, long ldb, int K, int brow, int bcol, f32x4 (&acc)[2][2][4][2]) {
#define SA(b, h) (shm + ((b) * 2 + (h)) * HT)
#define SB(b, h) (shm + (4 + (b) * 2 + (h)) * HT)
#define STAGE(P, BASE, LD, OFFS, br, kt) do { const char* _ub = (const char*)((BASE) + (long)(br) * (LD) + (long)(kt) * BK); \
    _Pragma("unroll") for (int _i = 0; _i < 2; ++_i) { \
      __builtin_amdgcn_global_load_lds((const unsigned*)(_ub + OFFS[_i]), \
        (__attribute__((address_space(3))) unsigned*)((char*)(P) + wv_s * 1024 + _i * 8192), 16, 0, 0); } } while (0)
#define LDA(dst, b, h) _Pragma("unroll") for (int m = 0; m < 4; ++m) _Pragma("unroll") for (int k = 0; k < 2; ++k) \
    dst[m][k] = *reinterpret_cast<const bf16x8*>((char*)SA(b, h) + lds_byte(wr * 64 + m * 16 + fr, k * 32 + fq * 8))
#define LDB(dst, b, h) _Pragma("unroll") for (int n = 0; n < 2; ++n) _Pragma("unroll") for (int k = 0; k < 2; ++k) \
    dst[n][k] = *reinterpret_cast<const bf16x8*>((char*)SB(b, h) + lds_byte(wc * 32 + n * 16 + fr, k * 32 + fq * 8))
#define MMA(ai, bj, At, Bq) do { __builtin_amdgcn_s_setprio(1); \
    _Pragma("unroll") for (int m = 0; m < 4; ++m) _Pragma("unroll") for (int n = 0; n < 2; ++n) _Pragma("unroll") for (int k = 0; k < 2; ++k) \
      acc[ai][bj][m][n] = __builtin_amdgcn_mfma_f32_16x16x32_bf16(At[m][k], Bq[n][k], acc[ai][bj][m][n], 0, 0, 0); \
    __builtin_amdgcn_s_setprio(0); } while (0)
#define WAIT_V(n) asm volatile("s_waitcnt vmcnt(" #n ")" ::: "memory")
#define WAIT_L(n) asm volatile("s_waitcnt lgkmcnt(" #n ")" ::: "memory")
#define BAR __builtin_amdgcn_s_barrier()
#define SCHED __builtin_amdgcn_sched_barrier(0)
  const int tid = wv_in * 64 + lane_id_opaque();
  const int wv_s = wv_in;
  const int wid = tid >> 6, lane = tid & 63, wr = wid >> 2, wc = wid & 3, fr = lane & 15, fq = lane >> 4;
#pragma unroll
  for (int a = 0; a < 2; ++a)
#pragma unroll
    for (int b = 0; b < 2; ++b)
#pragma unroll
      for (int m = 0; m < 4; ++m)
#pragma unroll
        for (int n = 0; n < 2; ++n) acc[a][b][m][n] = (f32x4){0.f, 0.f, 0.f, 0.f};
  bf16x8 At[4][2], B0[2][2], B1[2][2];
  const int nt = K / BK;
  unsigned offA[2], offB[2];
#pragma unroll
  for (int i = 0; i < 2; ++i) { int r_, c_; stage_rc(tid * 16 + i * 8192, r_, c_); offA[i] = (unsigned)(r_ * (int)lda + c_) * 2u; offB[i] = (unsigned)(r_ * (int)ldb + c_) * 2u; }
  WAIT_V(0);
  STAGE(SB(0, 0), Bt, ldb, offB, bcol, 0); STAGE(SA(0, 0), A, lda, offA, brow, 0);
  STAGE(SB(0, 1), Bt, ldb, offB, bcol + HALF, 0); STAGE(SA(0, 1), A, lda, offA, brow + HALF, 0);
  if (wr == 1) BAR;
  WAIT_V(4); BAR;
  STAGE(SB(1, 0), Bt, ldb, offB, bcol, 1); STAGE(SA(1, 0), A, lda, offA, brow, 1); STAGE(SB(1, 1), Bt, ldb, offB, bcol + HALF, 1);
  WAIT_V(6); BAR;
  for (int t = 0; t < nt - 2; t += 2) {
    LDB(B0, 0, 0); SCHED; LDA(At, 0, 0); STAGE(SA(1, 1), A, lda, offA, brow + HALF, t + 1);
    WAIT_L(8); BAR; WAIT_L(0); MMA(0, 0, At, B0); BAR; SCHED;
    LDB(B1, 0, 1); STAGE(SB(0, 0), Bt, ldb, offB, bcol, t + 2);
    BAR; WAIT_L(0); MMA(0, 1, At, B1); BAR;
    LDA(At, 0, 1); STAGE(SA(0, 0), A, lda, offA, brow, t + 2);
    BAR; WAIT_L(0); MMA(1, 0, At, B0); BAR; SCHED;
    STAGE(SB(0, 1), Bt, ldb, offB, bcol + HALF, t + 2);
    WAIT_V(6); BAR; MMA(1, 1, At, B1); BAR;
    LDB(B0, 1, 0); SCHED; LDA(At, 1, 0); STAGE(SA(0, 1), A, lda, offA, brow + HALF, t + 2);
    WAIT_L(8); BAR; WAIT_L(0); MMA(0, 0, At, B0); BAR; SCHED;
    LDB(B1, 1, 1); STAGE(SB(1, 0), Bt, ldb, offB, bcol, t + 3);
    BAR; WAIT_L(0); MMA(0, 1, At, B1); BAR;
    LDA(At, 1, 1); STAGE(SA(1, 0), A, lda, offA, brow, t + 3);
    BAR; WAIT_L(0); MMA(1, 0, At, B0); BAR; SCHED;
    STAGE(SB(1, 1), Bt, ldb, offB, bcol + HALF, t + 3);
    WAIT_V(6); BAR; MMA(1, 1, At, B1); BAR;
  }
  { LDB(B0, 0, 0); LDA(At, 0, 0); STAGE(SA(1, 1), A, lda, offA, brow + HALF, nt - 1);
    BAR; WAIT_L(0); MMA(0, 0, At, B0); BAR;
    LDB(B1, 0, 1); BAR; WAIT_L(0); MMA(0, 1, At, B1); BAR;
    LDA(At, 0, 1); WAIT_V(4); BAR; WAIT_L(0); MMA(1, 0, At, B0); MMA(1, 1, At, B1); BAR; }
  { LDB(B0, 1, 0); LDA(At, 1, 0); WAIT_V(2); BAR; WAIT_L(0); MMA(0, 0, At, B0); BAR;
    LDB(B1, 1, 1); WAIT_V(0); BAR; WAIT_L(0); MMA(0, 1, At, B1); BAR;
    LDA(At, 1, 1); BAR; WAIT_L(0); MMA(1, 0, At, B0); MMA(1, 1, At, B1); BAR; }
  if (wr == 0) BAR;
}

DEVI void tile_map(int nM, int nN, int idx, int& pm, int& pn) {
  int nwg = nM * nN; int q = nwg / 8, r = nwg % 8, xcd = idx % 8, off = idx / 8;
  int w = (xcd < r ? xcd * (q + 1) : r * (q + 1) + (xcd - r) * q) + off;
  int nig = 8 * nN, gid = w / nig, fm = gid * 8, gsz = min(nM - fm, 8);
  pm = fm + ((w % nig) % gsz); pn = (w % nig) / gsz;
}

struct ConvJob { const float* src; long ld; u16* dst; long ldd; int zero; };
DEVI void conv_load(const int tid, const ConvJob& j, float4 (&v)[4]) {
  const int rr2 = tid >> 4, cc = (tid & 15) * 4;
  const float* s0 = j.src + (long)(2 * rr2) * j.ld + cc;
  v[0] = ldnt4(s0); v[1] = ldnt4(s0 + j.ld);
  v[2] = ldnt4(s0 + 64); v[3] = ldnt4(s0 + j.ld + 64);
}
DEVI unsigned pk2(float a, float b) { return (unsigned)f2bf(a) | ((unsigned)f2bf(b) << 16); }
DEVI void conv_store(const int tid, unsigned char* smem, const ConvJob& j, const float4 (&v)[4]) {
  unsigned* T = (unsigned*)smem;
  const int rr2 = tid >> 4, cc = (tid & 15) * 4;
  const unsigned zm = j.zero ? 0u : 0xffffffffu;
#define pk2(a, b) (pk2(a, b) & zm)
  T[(cc + 0) * 36 + rr2] = pk2(v[0].x, v[1].x); T[(cc + 1) * 36 + rr2] = pk2(v[0].y, v[1].y);
  T[(cc + 2) * 36 + rr2] = pk2(v[0].z, v[1].z); T[(cc + 3) * 36 + rr2] = pk2(v[0].w, v[1].w);
  T[(cc + 64) * 36 + rr2] = pk2(v[2].x, v[3].x); T[(cc + 65) * 36 + rr2] = pk2(v[2].y, v[3].y);
  T[(cc + 66) * 36 + rr2] = pk2(v[2].z, v[3].z); T[(cc + 67) * 36 + rr2] = pk2(v[2].w, v[3].w);
#undef pk2
  __syncthreads();
#pragma unroll
  for (int h = 0; h < 2; ++h) {
    int n = (tid >> 3) + h * 64, kc = (tid & 7) * 4;
    uint4 o = *(const uint4*)(T + n * 36 + kc);
    *(uint4*)(j.dst + (long)n * j.ldd + kc * 2) = o;
  }
  __syncthreads();
}
DEVI ConvJob conv_job0(KP p, int idx) {
  ConvJob j; j.zero = 0;
  if (idx < 2176) { int nt = idx % 68, kt = idx / 68, n0 = nt * 128; j.zero = (n0 >= 4480 && n0 < 4608); int c0 = n0 < 4480 ? n0 : (j.zero ? 0 : n0 - 128);
    j.src = p->in[I_WIN] + (long)(kt * 64) * 8576 + c0; j.ld = 8576; j.dst = (u16*)(p->ws + OFF_A) + (long)n0 * 2048 + kt * 64; j.ldd = 2048; }
  else { int q = idx - 2176; j.ld = 1024; j.ldd = 384;
    if (q < 32) { int sec = q >> 3, nt = q & 7, d = sec & 1;
      j.src = (sec < 2 ? p->in[I_W2] : p->in[I_A2]) + (long)d * 64 * 1024 + nt * 128; j.dst = (u16*)(p->ws + OFF_LORAT) + (long)(sec * 1024 + nt * 128) * 384 + sec * 64; }
    else { int qq = q - 32, kt = qq >> 3, nt = qq & 7;
      j.src = p->in[I_G2] + (long)(kt * 64) * 1024 + nt * 128; j.dst = (u16*)(p->ws + OFF_LORAT) + (long)(4096 + nt * 128) * 384 + 256 + kt * 64; } }
  return j;
}
DEVI ConvJob conv_job7(KP p, int idx) {
  ConvJob j; j.zero = 0;
  { int kt = idx & 31, nt = (idx >> 5) + 2 * W13_BG_TILES, n0 = nt * 128, t = n0 >> 8, wi = n0 & 255; int c0 = wi < 128 ? t * 128 : DFF + t * 128;
    j.src = p->in[I_W13] + (long)(kt * 64) * (2 * DFF) + c0; j.ld = 2 * DFF; j.dst = (u16*)(p->ws + OFF_FX) + (long)n0 * 2048 + kt * 64; j.ldd = 2048; }
  return j;
}
DEVI ConvJob conv_job2(KP p, int idx) {
  ConvJob j; j.zero = 0;
  { int kt = idx % 88, nt = idx / 88, n0 = nt * 128;
    j.src = p->in[I_FW2] + (long)(kt * 64) * 2048 + n0; j.ld = 2048; j.dst = (u16*)(p->ws + OFF_W2T) + (long)n0 * DFF + kt * 64; j.ldd = DFF; }
  return j;
}
template <int WHICH>
DEVI void conv_run(KP p, const int tid, unsigned char* smem, int bid, int G) {
  const int njobs = WHICH == 0 ? 2224 : (WHICH == 1 ? (88 - 2 * W13_BG_TILES) * 32 : 1408);
  int idx = bid;
  if (idx >= njobs) return;
#define CJOB(i) (WHICH == 0 ? conv_job0(p, (i)) : (WHICH == 1 ? conv_job7(p, (i)) : conv_job2(p, (i))))
  ConvJob ja = CJOB(idx); float4 va[4]; conv_load(tid, ja, va);
  for (;;) {
    const int i1 = idx + G; const bool h1 = i1 < njobs;
    float4 vb[4];
    const ConvJob jb = CJOB(h1 ? i1 : idx); conv_load(tid, jb, vb);
    conv_store(tid, smem, ja, va);
    if (!h1) break;
    const int i2 = i1 + G; const bool h2 = i2 < njobs;
    ja = CJOB(h2 ? i2 : i1); conv_load(tid, ja, va);
    conv_store(tid, smem, jb, vb);
    if (!h2) break;
    idx = i2;
  }
#undef CJOB
}

DEVI void row_norm_phase(KP p, const int tid, int mode, int bid, int G) {
  const int lane = tid & 63, wave = tid >> 6;
  const float* MOD = (const float*)(p->ws + OFF_MOD);
  const float* adab = p->in[I_ADAB];
  const int nrows = (mode == 0) ? NTOK : NLAT;
  for (int r = bid * 8 + wave; r < nrows; r += G * 8) {
    const float* src; int mrow;
    if (mode == 0) { if (r < NLAT) { src = p->in[I_X] + (size_t)r * 2048; mrow = r >> 12; } else { src = p->in[I_CTX] + (size_t)(r - NLAT) * 2048; mrow = 2; } }
    else { src = p->out + (size_t)r * 2048; mrow = r >> 12; }
    float4 v[8]; float ss = 0.f;
#pragma unroll
    for (int i = 0; i < 8; ++i) { v[i] = ldnt4(src + (i * 64 + lane) * 4); ss += v[i].x * v[i].x + v[i].y * v[i].y + v[i].z * v[i].z + v[i].w * v[i].w; }
    ss = red64(ss);
    const float rs = rsqrtf(ss * (1.f / 2048.f) + 1e-6f);
    const float* nw = p->in[mode == 0 ? I_N1W : (mode == 1 ? I_N2W : I_NF)];
    const int shoff = (mode == 0) ? 0 : 6144, scoff = (mode == 0) ? 2048 : 8192;
    u16* dstb = (u16*)(p->ws + (mode == 0 ? OFF_B : OFF_A)) + (size_t)r * 2048;
#pragma unroll
    for (int i = 0; i < 8; ++i) {
      int c = (i * 64 + lane) * 4;
      float4 w4 = *(const float4*)(nw + c);
      float y0 = v[i].x * rs * w4.x, y1 = v[i].y * rs * w4.y, y2 = v[i].z * rs * w4.z, y3 = v[i].w * rs * w4.w;
      if (mode == 2) { *(float4*)(p->out + (size_t)r * 2048 + c) = make_float4(y0, y1, y2, y3); }
      else {
        float4 sh = *(const float4*)(MOD + mrow * 12288 + shoff + c), shb = *(const float4*)(adab + shoff + c);
        float4 sc = *(const float4*)(MOD + mrow * 12288 + scoff + c), scb = *(const float4*)(adab + scoff + c);
        y0 = y0 * (1.f + sc.x + scb.x) + sh.x + shb.x; y1 = y1 * (1.f + sc.y + scb.y) + sh.y + shb.y;
        y2 = y2 * (1.f + sc.z + scb.z) + sh.z + shb.z; y3 = y3 * (1.f + sc.w + scb.w) + sh.w + shb.w;
        uint2 o; o.x = (unsigned)f2bf(y0) | ((unsigned)f2bf(y1) << 16); o.y = (unsigned)f2bf(y2) | ((unsigned)f2bf(y3) << 16);
        *(uint2*)(dstb + c) = o;
      }
    }
  }
}

DEVI void phase0(KP p, const int tid, unsigned char* smem, int bid, int G) {
  {
    float* sv = (float*)smem;
    float* red = (float*)(smem + 24576);
    for (int i = tid; i < 3 * 2048; i += NTHR) {
      int j = i >> 11, k = i & 2047;
      float cv = (j < 2) ? p->in[I_C][j * 2048 + k] : p->in[I_CCTX][k];
      sv[i] = silu_(cv);
    }
    __syncthreads();
    float* MOD = (float*)(p->ws + OFF_MOD);
    const float* aw = p->in[I_ADAW];
    for (int cb = bid; cb < 256; cb += G) {
      const int cgq = tid % 12, ksl = tid / 12;
      float a0[4] = {0, 0, 0, 0}, a1[4] = {0, 0, 0, 0}, a2[4] = {0, 0, 0, 0};
      if (tid < 504) {
        const float* wp = aw + cb * 48 + cgq * 4;
#pragma unroll 7
        for (int k = ksl; k < 2048; k += 42) {
          float4 wv = ldnt4(wp + (size_t)k * 12288);
          float s0 = sv[k], s1 = sv[2048 + k], s2 = sv[4096 + k];
          a0[0] += s0 * wv.x; a0[1] += s0 * wv.y; a0[2] += s0 * wv.z; a0[3] += s0 * wv.w;
          a1[0] += s1 * wv.x; a1[1] += s1 * wv.y; a1[2] += s1 * wv.z; a1[3] += s1 * wv.w;
          a2[0] += s2 * wv.x; a2[1] += s2 * wv.y; a2[2] += s2 * wv.z; a2[3] += s2 * wv.w;
        }
        float* rp = red + (ksl * 12 + cgq) * 12;
#pragma unroll
        for (int e = 0; e < 4; ++e) { rp[e] = a0[e]; rp[4 + e] = a1[e]; rp[8 + e] = a2[e]; }
      }
      __syncthreads();
      if (tid < 144) {
        const int j = tid / 48, c = tid % 48;
        float sum = 0.f;
        for (int q = 0; q < 42; ++q) sum += red[(q * 12 + (c >> 2)) * 12 + j * 4 + (c & 3)];
        MOD[j * 12288 + cb * 48 + c] = sum;
      }
      __syncthreads();
    }
  }
  for (int g = G - 1 - bid; g < 64 && g >= 0; g += G) {
    float2* lamp = (float2*)smem;
    float2* bb = (float2*)(smem + 17408);
    float2* cm = (float2*)(smem + 17408 + 16384);
    float* ktab = (float*)(smem + 17408 + 32768);
    for (int i = tid; i < 2 * 17 * 64; i += NTHR) {
      int d = i / (17 * 64), tau = (i / 64) % 17, pp = i & 63;
      float are = p->in[I_SARE][(d * 64 + g) * 64 + pp], aim = p->in[I_SAIM][(d * 64 + g) * 64 + pp];
      float dt = expf(p->in[I_SLDT][d * 64 + g]);
      float re, im; cpow(are, aim, dt, (float)tau, re, im);
      lamp[i] = make_float2(re, im);
    }
    for (int i = tid; i < 2048; i += NTHR) {
      int d = i >> 10, pp = (i >> 4) & 63, h = i & 15;
      float are = p->in[I_SARE][(d * 64 + g) * 64 + pp], aim = p->in[I_SAIM][(d * 64 + g) * 64 + pp];
      float dt = expf(p->in[I_SLDT][d * 64 + g]);
      float lr, li; cpow(are, aim, dt, 1.f, lr, li);
      float nr = lr - 1.f, ni = li, den = 1.f / (are * are + aim * aim);
      float qr = (nr * are + ni * aim) * den, qi = (ni * are - nr * aim) * den;
      float br = p->in[I_SBRE][((size_t)(d * 64 + g) * 64 + pp) * 16 + h], bi = p->in[I_SBIM][((size_t)(d * 64 + g) * 64 + pp) * 16 + h];
      bb[i] = make_float2(qr * br - qi * bi, qr * bi + qi * br);
      int h2 = (i >> 6) & 15, p2 = i & 63;
      cm[i] = make_float2(p->in[I_SCRE][((size_t)(d * 64 + g) * 16 + h2) * 64 + p2], p->in[I_SCIM][((size_t)(d * 64 + g) * 16 + h2) * 64 + p2]);
    }
    __syncthreads();
    {
      const int d = tid >> 8, h = (tid >> 4) & 15, h2 = tid & 15;
      float acc[16];
#pragma unroll
      for (int tau = 0; tau < 16; ++tau) acc[tau] = 0.f;
      for (int pp = 0; pp < 64; ++pp) {
        const float2 c = cm[(d * 16 + h) * 64 + pp], b = bb[(d * 64 + pp) * 16 + h2];
        const float zr = c.x * b.x - c.y * b.y, zi = c.x * b.y + c.y * b.x;
#pragma unroll
        for (int tau = 0; tau < 16; ++tau) { const float2 l = lamp[(d * 17 + tau) * 64 + pp]; acc[tau] += zr * l.x - zi * l.y; }
      }
#pragma unroll
      for (int tau = 0; tau < 16; ++tau) ktab[(d * 16 + tau) * 256 + h * 16 + h2] = acc[tau];
    }
    __syncthreads();
    u16* BM_ = (u16*)(p->ws + OFF_BMAT) + (size_t)g * 65536;
    for (int ch = tid; ch < 8192; ch += NTHR) {
      int n = ch >> 5, k8 = (ch & 31) * 8;
      int d = n >> 7, part = (n >> 6) & 1, pp = n & 63, j = k8 >> 4, h0 = k8 & 15;
      float2 l = lamp[(d * 17 + (d == 0 ? 15 - j : j)) * 64 + pp];
      unsigned o[4];
#pragma unroll
      for (int e = 0; e < 8; ++e) {
        float2 b = bb[(d * 64 + pp) * 16 + h0 + e];
        float val = part == 0 ? (l.x * b.x - l.y * b.y) : (l.x * b.y + l.y * b.x);
        if (e & 1) o[e >> 1] |= (unsigned)f2bf(val) << 16; else o[e >> 1] = f2bf(val);
      }
      *(uint4*)(BM_ + n * 256 + k8) = make_uint4(o[0], o[1], o[2], o[3]);
    }
    u16* KC_ = (u16*)(p->ws + OFF_KC) + (size_t)g * 131072;
    for (int ch = tid; ch < 16384; ch += NTHR) {
      int n = ch >> 6, k8 = (ch & 63) * 8;
      int i = n >> 4, h = n & 15;
      unsigned o[4];
#pragma unroll
      for (int e = 0; e < 8; ++e) {
        int k = k8 + e; float val;
        if (k < 256) {
          int j = k >> 4, h2 = k & 15;
          val = 0.f;
          if (j <= i) val += ktab[(0 * 16 + (i - j)) * 256 + h * 16 + h2];
          if (j >= i) val += ktab[(1 * 16 + (j - i)) * 256 + h * 16 + h2];
          if (j == i && h == h2) val += p->in[I_SD][g * 16 + h];
        } else {
          int kk = k - 256, d = kk >> 7, part = (kk >> 6) & 1, pp = kk & 63;
          int ex = d == 0 ? i + 1 : 16 - i;
          float2 c = cm[(d * 16 + h) * 64 + pp], l = lamp[(d * 17 + ex) * 64 + pp];
          val = part == 0 ? (c.x * l.x - c.y * l.y) : -(c.x * l.y + c.y * l.x);
        }
        if (e & 1) o[e >> 1] |= (unsigned)f2bf(val) << 16; else o[e >> 1] = f2bf(val);
      }
      *(uint4*)(KC_ + n * 512 + k8) = make_uint4(o[0], o[1], o[2], o[3]);
    }
    __syncthreads();
  }
  if (G > 128) { if (bid < G - 64) conv_run<0>(p, tid, smem, bid, G - 64); }
  else conv_run<0>(p, tid, smem, bid, G);
  {
    u16* LT = (u16*)(p->ws + OFF_LORAT);
    for (int ch = bid * NTHR + tid; ch < 5120 * 48; ch += G * NTHR) {
      int n = ch / 48, rem = ch % 48, kb = rem >> 3, part = rem & 7, sec = n >> 10;
      bool nz = (sec < 4) ? (kb == sec) : (kb >= 4);
      if (!nz) *(uint4*)(LT + (size_t)n * 384 + kb * 64 + part * 8) = make_uint4(0, 0, 0, 0);
    }
  }
}

DEVI float red8(float x) { x += dppf<0xB1>(x); x += dppf<0x4E>(x); x += dppf<0x141>(x); return x; }
DEVI void phase3_prep(KP p, const int tid, int bid, int G) {
  const int slot = tid >> 7, t = tid & 127;
  const h16* ZRW = (const h16*)(p->ws + OFF_D);
  h16* Rb = (h16*)(p->ws + OFF_A); h16* Kb = Rb + (size_t)NTOK * 1024;
  h16* Vb = (h16*)(p->ws + OFF_B); h16* KKb = Vb + (size_t)NTOK * 1024;
  u16* LA = (u16*)(p->ws + OFF_LA);
  const float* mu = p->in[I_MU];
  for (int r = bid * 4 + slot; r < NTOK; r += G * 4) {
    int ru, rd, rl, rr; float fu, fd, fl, frr;
    if (r < NLAT) { int l = r & 4095, gr = l >> 6, gc = l & 63;
      fu = gr > 0; fd = gr < 63; fl = gc > 0; frr = gc < 63;
      ru = gr > 0 ? r - 64 : r; rd = gr < 63 ? r + 64 : r; rl = gc > 0 ? r - 1 : r; rr = gc < 63 ? r + 1 : r; }
    else { int l = (r - NLAT) & 255; fu = l > 0; fd = l < 255; fl = 0.f; frr = 0.f; ru = l > 0 ? r - 1 : r; rd = l < 255 ? r + 1 : r; rl = r; rr = r; }
    const float inv = 1.f / (fu + fd + fl + frr);
    fu *= inv; fd *= inv; fl *= inv; frr *= inv;
#define ZS8(c, o) do { h16x8 z_ = *(const h16x8*)(ZRW + (size_t)r * ZRWP + (c)); h16x8 u_ = *(const h16x8*)(ZRW + (size_t)ru * ZRWP + (c)); \
      h16x8 d_ = *(const h16x8*)(ZRW + (size_t)rd * ZRWP + (c)); h16x8 l_ = *(const h16x8*)(ZRW + (size_t)rl * ZRWP + (c)); h16x8 r_ = *(const h16x8*)(ZRW + (size_t)rr * ZRWP + (c)); \
      float4 ma_ = *(const float4*)(mu + (c)), mb_ = *(const float4*)(mu + (c) + 4); \
      const float mm_[8] = {ma_.x, ma_.y, ma_.z, ma_.w, mb_.x, mb_.y, mb_.z, mb_.w}; \
      _Pragma("unroll") for (int e = 0; e < 8; ++e) { float z = (float)z_[e]; \
        float m = fu * (float)u_[e] + fd * (float)d_[e] + fl * (float)l_[e] + frr * (float)r_[e]; o[e] = z + (m - z) * mm_[e]; } } while (0)
    float zr[8], zk[8], zv[8];
    ZS8(8 * t, zr); ZS8(1024 + 8 * t, zk); ZS8(2048 + 8 * t, zv);
    h16x8 o;
#pragma unroll
    for (int e = 0; e < 8; ++e) o[e] = (h16)zr[e];
    *(h16x8*)(Rb + (size_t)r * 1024 + 8 * t) = o;
#pragma unroll
    for (int e = 0; e < 8; ++e) o[e] = (h16)zk[e];
    *(h16x8*)(Kb + (size_t)r * 1024 + 8 * t) = o;
#pragma unroll
    for (int e = 0; e < 8; ++e) o[e] = (h16)zv[e];
    *(h16x8*)(Vb + (size_t)r * 1024 + 8 * t) = o;
    {
      float4 ka_ = *(const float4*)(p->in[I_KK] + 8 * t), kb_ = *(const float4*)(p->in[I_KK] + 8 * t + 4);
      const float kw[8] = {ka_.x, ka_.y, ka_.z, ka_.w, kb_.x, kb_.y, kb_.z, kb_.w};
      float kx[8]; float ss = 0.f;
#pragma unroll
      for (int e = 0; e < 8; ++e) { kx[e] = zk[e] * kw[e]; ss += kx[e] * kx[e]; }
      ss = red8(ss);
      const float rs = rsqrtf(ss + 1e-12f);
#pragma unroll
      for (int e = 0; e < 8; ++e) o[e] = (h16)(kx[e] * rs);
      *(h16x8*)(KKb + (size_t)r * 1024 + 8 * t) = o;
    }
    if (t < 48) {
      float zl[8];
      ZS8(3072 + 8 * t, zl);
      const int c = 8 * t;
      unsigned w[4];
#pragma unroll
      for (int e = 0; e < 8; e += 2) {
        float a = zl[e], b = zl[e + 1];
        if (c < 128) { a = tanh_(a); b = tanh_(b); } else if (c >= 256) { a = sigm(a); b = sigm(b); }
        w[e >> 1] = (unsigned)f2bf(a) | ((unsigned)f2bf(b) << 16);
      }
      *(uint4*)(LA + (size_t)r * 384 + c) = make_uint4(w[0], w[1], w[2], w[3]);
    }
#undef ZS8
  }
}

DEVI void phase4_chunkscan(KP p, const int tid, unsigned char* smem, int bid, int G) {
  const int pp = tid & 63, sl = tid >> 6;
  const float* XLOC = (const float*)p->out;
  u16* U2X = (u16*)(p->ws + OFF_C);
  float2* Fs = (float2*)smem;
  for (int combo = bid; combo < 256; combo += G) {
    const int b = combo >> 7, g = (combo >> 1) & 63, d = combo & 1;
    float are = p->in[I_SARE][(d * 64 + g) * 64 + pp], aim = p->in[I_SAIM][(d * 64 + g) * 64 + pp];
    float dt = expf(p->in[I_SLDT][d * 64 + g]);
    float mr, mi; cpow(are, aim, dt, 16.f, mr, mi);
    float xr[34], xi[34];
#pragma unroll
    for (int i = 0; i < 34; ++i) {
      int q = sl * 34 + i;
      int chunk = q < 16 ? 512 + b * 16 + (d ? 15 - q : q) : b * 256 + (d ? 255 - (q - 16) : (q - 16));
      const float* src = XLOC + ((size_t)g * 544 + chunk) * 256 + d * 128 + pp;
      xr[i] = src[0]; xi[i] = src[64];
    }
    float sr = 0.f, si = 0.f;
#pragma unroll
    for (int i = 0; i < 34; ++i) { float nr = mr * sr - mi * si + xr[i], ni = mr * si + mi * sr + xi[i]; sr = nr; si = ni; }
    Fs[sl * 64 + pp] = make_float2(sr, si);
    float m34r = 1.f, m34i = 0.f;
#pragma unroll
    for (int i = 0; i < 34; ++i) { float nr = m34r * mr - m34i * mi, ni = m34r * mi + m34i * mr; m34r = nr; m34i = ni; }
    __syncthreads();
    float cr = 0.f, ci = 0.f;
#pragma unroll
    for (int s2 = 0; s2 < 7; ++s2) {
      if (s2 < sl) { float2 f = Fs[s2 * 64 + pp]; float nr = m34r * cr - m34i * ci + f.x, ni = m34r * ci + m34i * cr + f.y; cr = nr; ci = ni; }
    }
    sr = cr; si = ci;
#pragma unroll
    for (int i = 0; i < 34; ++i) {
      int q = sl * 34 + i;
      if (q >= 16) {
        int chunk = b * 256 + (d ? 255 - (q - 16) : (q - 16));
        u16* dst = U2X + (size_t)g * GS + (size_t)chunk * 512 + 256 + d * 128 + pp;
        dst[0] = f2bf(sr); dst[64] = f2bf(si);
      }
      float nr = mr * sr - mi * si + xr[i], ni = mr * si + mi * sr + xi[i]; sr = nr; si = ni;
    }
    __syncthreads();
  }
}

struct CJ2 { const float* src; long ld; u16* dst; long ldd; };
DEVI CJ2 cjob_bg(KP p, int idx, int ng) {
  CJ2 j;
  if (idx < 512) { const int nt = idx & 15, kt = idx >> 4, wi = ng * 4; const int sc = wi < 128 ? nt * 128 + wi : 2048 + nt * 128 + wi - 128;
    j.src = p->in[I_GLUW] + (long)(kt * 32) * 4096 + sc; j.ld = 4096; j.dst = (u16*)(p->ws + OFF_GLUT) + (long)(nt * 256 + ng * 4) * 1024 + kt * 32; j.ldd = 1024; }
  else if (idx < 768) { const int q = idx - 512, nt = q & 7, kt = q >> 3;
    j.src = p->in[I_RWP] + (long)(kt * 32) * 2048 + nt * 256 + ng * 4; j.ld = 2048; j.dst = (u16*)(p->ws + OFF_RWPT) + (long)(nt * 256 + ng * 4) * 1024 + kt * 32; j.ldd = 1024; }
  else if (idx < 1280) { const int q = idx - 768, nt = q & 7, kt = q >> 3;
    j.src = p->in[I_WO] + (long)(kt * 32) * 2048 + nt * 256 + ng * 4; j.ld = 2048; j.dst = (u16*)(p->ws + OFF_WOT) + (long)(nt * 256 + ng * 4) * 2048 + kt * 32; j.ldd = 2048; }
  else { const int q = idx - 1280, nt = q % W13_BG_TILES, kt = q / W13_BG_TILES, wi = ng * 4; const int sc = wi < 128 ? nt * 128 + wi : DFF + nt * 128 + wi - 128;
    j.src = p->in[I_W13] + (long)(kt * 32) * (2 * DFF) + sc; j.ld = 2 * DFF; j.dst = w13_tile_base(p->ws, nt) + (long)(ng * 4) * 2048 + kt * 32; j.ldd = 2048; }
  return j;
}
DEVI void cj_load(const CJ2& j, int kg, float4 (&v)[8]) {
  const float* s0 = j.src + (long)(kg * 8) * j.ld;
#pragma unroll
  for (int i = 0; i < 8; ++i) v[i] = ldnt4(s0 + (long)i * j.ld);
}
DEVI void cj_store(const CJ2& j, int kg, const float4 (&v)[8]) {
  u16* d0 = j.dst + kg * 8;
  *(uint4*)(d0) = make_uint4(pk2(v[0].x, v[1].x), pk2(v[2].x, v[3].x), pk2(v[4].x, v[5].x), pk2(v[6].x, v[7].x));
  *(uint4*)(d0 + j.ldd) = make_uint4(pk2(v[0].y, v[1].y), pk2(v[2].y, v[3].y), pk2(v[4].y, v[5].y), pk2(v[6].y, v[7].y));
  *(uint4*)(d0 + 2 * j.ldd) = make_uint4(pk2(v[0].z, v[1].z), pk2(v[2].z, v[3].z), pk2(v[4].z, v[5].z), pk2(v[6].z, v[7].z));
  *(uint4*)(d0 + 3 * j.ldd) = make_uint4(pk2(v[0].w, v[1].w), pk2(v[2].w, v[3].w), pk2(v[4].w, v[5].w), pk2(v[6].w, v[7].w));
}

constexpr int TB = 32, STEPF = 336, BUFB = TB * STEPF * 4, YB_OFF = 2 * BUFB, YG = 16 * 68, YBB = (TB / 4) * YG * 4, NBLK = 4352 / TB;
constexpr int VT_OFF = YB_OFF + 2 * YBB, VTB = 16 * TB * 4;
typedef float f2 __attribute__((ext_vector_type(2)));
DEVI int tokrow(int s, int b, int d) { return s < 256 ? NLAT + b * 256 + (d ? 255 - s : s) : b * 4096 + (d ? 4095 - (s - 256) : (s - 256)); }

template <bool LAT>
DEVI void scan_block(const float* bp, const float* vt, float* yp, int ksl, int rowl, int lin, f2& sa, f2& sb) {
  float4 W[3], KA[3], KD[3], KK[3], R[3];
  float4 V4[8];
#pragma unroll
  for (int i = 0; i < 8; ++i) V4[i] = *(const float4*)(vt + rowl * TB + i * 4);
#define LDSTEP(i, t) do { const float* q_ = bp + (t) * STEPF + ksl * 4; W[i] = *(const float4*)(q_); KA[i] = *(const float4*)(q_ + 64); \
    KD[i] = *(const float4*)(q_ + 128); KK[i] = *(const float4*)(q_ + 192); if (LAT) R[i] = *(const float4*)(q_ + 256); } while (0)
  LDSTEP(0, 0); LDSTEP(1, 1);
  float yacc[4];
#pragma unroll
  for (int t = 0; t < TB; ++t) {
    if (t + 2 < TB) LDSTEP((t + 2) % 3, t + 2);
    const int i = t % 3;
    const f2 kk01 = {KK[i].x, KK[i].y}, kk23 = {KK[i].z, KK[i].w};
    f2 pr = sa * kk01; pr = sb * kk23 + pr;
    const float v = V4[t >> 2][t & 3];
    const f2 vv = {v, v};
    const f2 kd01 = {KD[i].x, KD[i].y}, kd23 = {KD[i].z, KD[i].w}, w01 = {W[i].x, W[i].y}, w23 = {W[i].z, W[i].w};
    const f2 qa = sa * w01 + vv * kd01, qb = sb * w23 + vv * kd23;
    const float u = red16(pr.x + pr.y);
    const f2 uu = {u, u};
    const f2 ka01 = {KA[i].x, KA[i].y}, ka23 = {KA[i].z, KA[i].w};
    sa = qa - uu * ka01; sb = qb - uu * ka23;
    if (LAT) {
      const f2 r01 = {R[i].x, R[i].y}, r23 = {R[i].z, R[i].w};
      f2 y = sa * r01; y = sb * r23 + y;
      yacc[t & 3] = y.x + y.y;
      if ((t & 3) == 3) *(float4*)(yp + (t >> 2) * YG + lin * 4 + (lin >> 4) * 4) = make_float4(yacc[0], yacc[1], yacc[2], yacc[3]);
    }
  }
#undef LDSTEP
}

DEVI void phase5_scan(KP p, const int tid, unsigned char* smem, int bid, int G) {
  for (int unit = bid; unit < 256; unit += G) {
    const int chain = unit >> 2, quarter = unit & 3, b = chain >> 5, head = (chain >> 1) & 15, d = chain & 1;
    const h16* Rb = (const h16*)(p->ws + OFF_A); const h16* Kb = Rb + (size_t)NTOK * 1024;
    const h16* Vb = (const h16*)(p->ws + OFF_B); const h16* KKb = Vb + (size_t)NTOK * 1024;
    const h16* EWb = (const h16*)(p->ws + OFF_FX) + (size_t)d * NTOK * 1024;
    const h16* Ab = (const h16*)(p->ws + OFF_FX) + (size_t)(2 + d) * NTOK * 1024;
    h16* Yd = (h16*)(p->ws + OFF_D) + (size_t)d * NLAT * 1024;
    const bool loader = tid >= 256;
    const int lt = tid - 256, lst = (lt >> 3) & 31, cg8 = lt & 7;
    const int lane = tid & 63, rowl = ((tid >> 6) & 3) * 4 + (lane >> 4), ksl = lane & 15, lin = tid & 255;
    f2 sa = {0.f, 0.f}, sb = {0.f, 0.f};
    float ka[8];
    float4 cv[8];
    const bool bgfirst = (unit == bid);
    constexpr int NBG = 1280 + W13_BG_TILES * 64;
    const int bg_nsl = (NBG + G - 1) / G;
    h16x8 rR, rK, rKK, rEW, rA; h16x2 rV;
#define LOADRAW(jb) do { int tok_ = tokrow((jb) * TB + lst, b, d); size_t base_ = (size_t)tok_ * 1024 + head * 64 + cg8 * 8; \
      rR = *(const h16x8*)(Rb + base_); rK = *(const h16x8*)(Kb + base_); rKK = *(const h16x8*)(KKb + base_); \
      rEW = *(const h16x8*)(EWb + base_); rA = *(const h16x8*)(Ab + base_); \
      rV = *(const h16x2*)(Vb + (size_t)tok_ * 1024 + head * 64 + quarter * 16 + cg8 * 2); } while (0)
#define CONVERT(bufi) do { float* dst_ = (float*)(smem + (bufi) * BUFB) + lst * STEPF; \
      float fw[8], fkka[8], fkd[8], fkk[8], frv[8]; \
      _Pragma("unroll") for (int e = 0; e < 8; ++e) { float a_ = (float)rA[e], kk_ = (float)rKK[e]; \
        fw[e] = __expf(-(float)rEW[e]); fkka[e] = kk_ * a_; fkd[e] = (float)rK[e] * (1.f + (a_ - 1.f) * ka[e]); fkk[e] = kk_; frv[e] = (float)rR[e]; } \
      *(float4*)(dst_ + cg8 * 8) = make_float4(fw[0], fw[1], fw[2], fw[3]); *(float4*)(dst_ + cg8 * 8 + 4) = make_float4(fw[4], fw[5], fw[6], fw[7]); \
      *(float4*)(dst_ + 64 + cg8 * 8) = make_float4(fkka[0], fkka[1], fkka[2], fkka[3]); *(float4*)(dst_ + 64 + cg8 * 8 + 4) = make_float4(fkka[4], fkka[5], fkka[6], fkka[7]); \
      *(float4*)(dst_ + 128 + cg8 * 8) = make_float4(fkd[0], fkd[1], fkd[2], fkd[3]); *(float4*)(dst_ + 128 + cg8 * 8 + 4) = make_float4(fkd[4], fkd[5], fkd[6], fkd[7]); \
      *(float4*)(dst_ + 192 + cg8 * 8) = make_float4(fkk[0], fkk[1], fkk[2], fkk[3]); *(float4*)(dst_ + 192 + cg8 * 8 + 4) = make_float4(fkk[4], fkk[5], fkk[6], fkk[7]); \
      *(float4*)(dst_ + 256 + cg8 * 8) = make_float4(frv[0], frv[1], frv[2], frv[3]); *(float4*)(dst_ + 256 + cg8 * 8 + 4) = make_float4(frv[4], frv[5], frv[6], frv[7]); \
      { float* vt_ = (float*)(smem + VT_OFF + (bufi) * VTB); vt_[(cg8 * 2) * TB + lst] = (float)rV[0]; vt_[(cg8 * 2 + 1) * TB + lst] = (float)rV[1]; } } while (0)
#define FLUSHY(jb) do { if (lt < 128) { const int t4_ = lt >> 4, row_ = lt & 15; \
      const float* yb_ = (const float*)(smem + YB_OFF + ((jb) & 1) * YBB) + t4_ * YG + row_ * 68; \
      float4 acc_ = *(const float4*)(yb_); \
      _Pragma("unroll") for (int l_ = 1; l_ < 16; ++l_) { const float4 q_ = *(const float4*)(yb_ + l_ * 4); acc_.x += q_.x; acc_.y += q_.y; acc_.z += q_.z; acc_.w += q_.w; } \
      const float ys_[4] = {acc_.x, acc_.y, acc_.z, acc_.w}; \
      _Pragma("unroll") for (int e_ = 0; e_ < 4; ++e_) { const int tok_ = tokrow((jb) * TB + t4_ * 4 + e_, b, d); \
        Yd[(size_t)tok_ * 1024 + head * 64 + quarter * 16 + row_] = (h16)ys_[e_]; } } } while (0)
    if (loader) {
#pragma unroll
      for (int e = 0; e < 8; ++e) ka[e] = p->in[I_KA][head * 64 + cg8 * 8 + e];
      LOADRAW(0); CONVERT(0); LOADRAW(1);
    }
    __syncthreads();
    for (int jb = 0; jb < NBLK; ++jb) {
      if (!loader) {
        const float* bp = (const float*)(smem + (jb & 1) * BUFB);
        float* yp = (float*)(smem + YB_OFF + (jb & 1) * YBB);
        const float* vt = (const float*)(smem + VT_OFF + (jb & 1) * VTB);
        if (jb < 8) scan_block<false>(bp, vt, yp, ksl, rowl, lin, sa, sb);
        else scan_block<true>(bp, vt, yp, ksl, rowl, lin, sa, sb);
      } else {
        if (jb + 1 < NBLK) CONVERT((jb + 1) & 1);
        if (jb + 2 < NBLK) LOADRAW(jb + 2);
        if (jb - 1 >= 8) FLUSHY(jb - 1);
        if (bgfirst && jb >= 4 && jb < 4 + 8 * bg_nsl && bid + G * ((jb - 4) / 8) < NBG) {
          const int ph20 = (jb - 4) % 8, sj = (jb - 4) / 8;
          if (ph20 == 0) { const CJ2 cj = cjob_bg(p, bid + G * sj, lt & 63); cj_load(cj, lt >> 6, cv); }
          else if (ph20 == 1) { const CJ2 cj = cjob_bg(p, bid + G * sj, lt & 63); cj_store(cj, lt >> 6, cv); }
        }
      }
      __syncthreads();
    }
    if (loader) FLUSHY(NBLK - 1);
    __syncthreads();
#undef LOADRAW
#undef CONVERT
#undef FLUSHY
  }
}

DEVI void phase6_post(KP p, const int tid, int bid, int G) {
  const int t = tid;
  const h16* Rb = (const h16*)(p->ws + OFF_A); const h16* Kb = Rb + (size_t)NTOK * 1024;
  const h16* Vb = (const h16*)(p->ws + OFF_B);
  const h16* A0b = (const h16*)(p->ws + OFF_FX) + (size_t)2 * NTOK * 1024; const h16* A1b = A0b + (size_t)NTOK * 1024; const h16* Gb = A1b + (size_t)NTOK * 1024;
  const h16* Y0 = (const h16*)(p->ws + OFF_D); const h16* Y1 = Y0 + (size_t)NLAT * 1024;
  u16* YRW = (u16*)(p->ws + OFF_C);
  const float2 kav = *(const float2*)(p->in[I_KA] + 2 * t), rkv = *(const float2*)(p->in[I_RK] + 2 * t);
  const float2 lw = *(const float2*)(p->in[I_LNW] + 2 * t), lb = *(const float2*)(p->in[I_LNB] + 2 * t);
  for (int r = bid; r < NLAT; r += G) {
    size_t o = (size_t)r * 1024 + 2 * t;
    h16x2 y0 = *(const h16x2*)(Y0 + o), y1 = *(const h16x2*)(Y1 + o);
    float ya = (float)y0[0] + (float)y1[0], yb = (float)y0[1] + (float)y1[1];
    float mean = red32(ya + yb) * (1.f / 64.f);
    float da = ya - mean, db = yb - mean;
    float var = red32(da * da + db * db) * (1.f / 64.f);
    float rs = rsqrtf(var + 64e-5f);
    h16x2 r2 = *(const h16x2*)(Rb + o), k2 = *(const h16x2*)(Kb + o), v2 = *(const h16x2*)(Vb + o);
    h16x2 a0 = *(const h16x2*)(A0b + o), a1 = *(const h16x2*)(A1b + o), g2 = *(const h16x2*)(Gb + o);
    float ra = (float)r2[0], rb = (float)r2[1], ka_ = (float)k2[0], kb_ = (float)k2[1];
    float kd0a = ka_ * (1.f + ((float)a0[0] - 1.f) * kav.x), kd0b = kb_ * (1.f + ((float)a0[1] - 1.f) * kav.y);
    float kd1a = ka_ * (1.f + ((float)a1[0] - 1.f) * kav.x), kd1b = kb_ * (1.f + ((float)a1[1] - 1.f) * kav.y);
    float bs = red32(ra * (kd0a + kd1a) * rkv.x + rb * (kd0b + kd1b) * rkv.y);
    float oa = (da * rs * lw.x + lb.x + bs * (float)v2[0]) * (float)g2[0];
    float ob = (db * rs * lw.y + lb.y + bs * (float)v2[1]) * (float)g2[1];
    *(unsigned*)(YRW + o) = (unsigned)f2bf(oa) | ((unsigned)f2bf(ob) << 16);
  }
}

DEVI void phase7_conv(KP p, const int tid, unsigned char* smem, int bid, int G) { conv_run<1>(p, tid, smem, bid, G); }

#define XB_XCNT(j) (64 * (j))
#define XB_XSUB(j) (1024 + 64 * (j))
#define XB_XGEN(j) (2048 + 64 * (j))
#define XB_TOP 3072
#define XB_TOPGEN 3136
DEVI unsigned xb_ld(unsigned* q) { return __hip_atomic_load(q, __ATOMIC_RELAXED, __HIP_MEMORY_SCOPE_AGENT); }
DEVI unsigned xb_add(unsigned* q, unsigned v) { return __hip_atomic_fetch_add(q, v, __ATOMIC_RELAXED, __HIP_MEMORY_SCOPE_AGENT); }
DEVI unsigned xb_xcc_id() { return (unsigned)__builtin_amdgcn_s_getreg((3 << 11) | 20) & 0xFu; }
DEVI void grid_barrier(unsigned* bar, const unsigned x, const unsigned nloc, const unsigned nx, const int tid) {
  asm volatile("s_waitcnt vmcnt(0) lgkmcnt(0)" ::: "memory");
  __syncthreads();
  if (tid == 0) {
    const unsigned old = xb_add(&bar[XB_XSUB(x)], 1u);
    const unsigned gen = old / nloc;
    if (old + 1u == (gen + 1u) * nloc) {
      __builtin_amdgcn_fence(__ATOMIC_RELEASE, "agent");
      asm volatile("s_waitcnt vmcnt(0)" ::: "memory");
      const unsigned og = xb_add(&bar[XB_TOP], 1u);
      const unsigned tg = og / nx;
      if (og + 1u == (tg + 1u) * nx) xb_add(&bar[XB_TOPGEN], 1u);
      else { while (xb_ld(&bar[XB_TOPGEN]) == tg) __builtin_amdgcn_s_sleep(1); }
      __builtin_amdgcn_fence(__ATOMIC_ACQUIRE, "agent");
      xb_add(&bar[XB_XGEN(x)], 1u);
      asm volatile("s_waitcnt vmcnt(0)" ::: "memory");
    } else {
      while (xb_ld(&bar[XB_XGEN(x)]) == gen) __builtin_amdgcn_s_sleep(1);
      __builtin_amdgcn_fence(__ATOMIC_ACQUIRE, "agent");
      asm volatile("s_waitcnt vmcnt(0)" ::: "memory");
    }
  }
  __syncthreads();
}

template <int ph>
DEVI void run_phase(KP p, const int wv, const int tid, const int bid, const int G, unsigned char* smem) {
  {
    switch (ph) {
      case 0: phase0(p, tid, smem, bid, G); break;
      case 1: row_norm_phase(p, tid, 0, bid, G); break;
      case 3: phase3_prep(p, tid, bid, G); break;
      case 4: phase4_chunkscan(p, tid, smem, bid, G); break;
      case 5: phase5_scan(p, tid, smem, bid, G); break;
      case 6: phase6_post(p, tid, bid, G); break;
      case 7: phase7_conv(p, tid, smem, bid, G); break;
      case 9: row_norm_phase(p, tid, 1, bid, G); break;
      case 12: row_norm_phase(p, tid, 2, bid, G); break;
      default: break;
    }
    int nunits = 0, nsub = 1;
    switch (ph) {
      case 2: nunits = 1124; break;
      case 3: nunits = 192; break;
      case 4: nunits = 680; break;
      case 5: nunits = 128; break;
      case 7: nunits = 256; nsub = 3; break;
      case 8: nunits = 256; break;
      case 10: nunits = 1408; break;
      case 11: nunits = 256; break;
      default: break;
    }
    if (nunits > 0) __syncthreads();
    for (int it0 = 0;; ++it0) {
      const int unit = bid + it0 * G;
      if (unit >= nunits) break;
#pragma unroll
     for (int sub = 0; sub < (ph == 7 ? 3 : 1); ++sub) {
      const u16* A = nullptr; const u16* Bt = nullptr; long lda = 0, ldb = 0; int K = 0, brow = 0, bcol = 0, pm = 0, pn = 0, e0 = 0;
      switch (ph) {
        case 2:
          if (unit < 1088) { tile_map(32, 34, unit, pm, pn); brow = pm * 256; } else { tile_map(2, 18, unit - 1088, pm, pn); brow = NLAT + pm * 256; }
          A = (const u16*)(p->ws + OFF_B); lda = 2048; Bt = (const u16*)(p->ws + OFF_A); ldb = 2048; K = 2048; bcol = pn * 256; break;
        case 3:
          e0 = unit / 3; pm = unit % 3; A = (const u16*)(p->ws + OFF_C) + (size_t)e0 * GS; lda = 512; brow = pm * 256;
          Bt = (const u16*)(p->ws + OFF_BMAT) + (size_t)e0 * 65536; ldb = 256; K = 256; bcol = 0; break;
        case 4:
          tile_map(34, 20, unit, pm, pn); { const int kwin = pn < 8 ? 0 : (pn < 16 ? 128 : 256);
          A = (const u16*)(p->ws + OFF_LA) + kwin; lda = 384; brow = pm * 256;
          Bt = (const u16*)(p->ws + OFF_LORAT) + kwin; ldb = 384; K = 128; bcol = pn * 256; } break;
        case 5:
          e0 = unit >> 1; pm = unit & 1; A = (const u16*)(p->ws + OFF_C) + (size_t)e0 * GS; lda = 512; brow = pm * 256;
          Bt = (const u16*)(p->ws + OFF_KC) + (size_t)e0 * 131072; ldb = 512; K = 512; bcol = 0; break;
        case 7:
          tile_map(32, 8, unit, pm, pn); brow = pm * 256; lda = 1024; ldb = 1024; K = 1024;
          if (sub < 2) { A = (const u16*)(p->ws + OFF_D + 33554432); Bt = (const u16*)(p->ws + OFF_GLUT); bcol = (pn * 2 + sub) * 256; }
          else { A = (const u16*)(p->ws + OFF_C); Bt = (const u16*)(p->ws + OFF_RWPT); bcol = pn * 256; }
          break;
        case 8:
          tile_map(32, 8, unit, pm, pn); A = (const u16*)(p->ws + OFF_B); lda = 2048; brow = pm * 256;
          Bt = (const u16*)(p->ws + OFF_WOT); ldb = 2048; K = 2048; bcol = pn * 256; break;
        case 10:
          tile_map(32, 44, unit, pm, pn); A = (const u16*)(p->ws + OFF_A); lda = 2048; brow = pm * 256;
          Bt = (const u16*)w13_tile_base(p->ws, pn); ldb = 2048; K = 2048; bcol = 0; break;
        default:
          tile_map(32, 8, unit, pm, pn); A = (const u16*)(p->ws + OFF_C); lda = DFF; brow = pm * 256;
          Bt = (const u16*)(p->ws + OFF_W2T); ldb = DFF; K = DFF; bcol = pn * 256; break;
      }
      f32x4 acc[2][2][4][2];
      gemm_core(wv, (u16*)smem, A, lda, Bt, ldb, K, brow, bcol, acc);
      const int te = wv * 64 + lane_id_opaque();
      const int wid = te >> 6, lane = te & 63, wr = wid >> 2, wc = wid & 3, fr = lane & 15, fq = lane >> 4;
#define QWRITE(Tp, ai, bj) _Pragma("unroll") for (int m = 0; m < 4; ++m) _Pragma("unroll") for (int n = 0; n < 2; ++n) _Pragma("unroll") for (int j = 0; j < 4; ++j) \
        (Tp)[(wr * 64 + m * 16 + fq * 4 + j) * 132 + wc * 32 + n * 16 + fr] = acc[ai][bj][m][n][j];
#define EPI_ALL(BODY) _Pragma("unroll") for (int ai = 0; ai < 2; ++ai) _Pragma("unroll") for (int bj = 0; bj < 2; ++bj) { __builtin_amdgcn_sched_barrier(0); \
      _Pragma("unroll") for (int m = 0; m < 4; ++m) _Pragma("unroll") for (int n = 0; n < 2; ++n) _Pragma("unroll") for (int j = 0; j < 4; ++j) { \
        const int row = brow + ai * 128 + wr * 64 + m * 16 + fq * 4 + j; const int col = bcol + bj * 128 + wc * 32 + n * 16 + fr; \
        const float v = acc[ai][bj][m][n][j]; BODY } }
#define EPI_HALF(BODY) _Pragma("unroll") for (int ai = 0; ai < 2; ++ai) { __builtin_amdgcn_sched_barrier(0); \
      _Pragma("unroll") for (int m = 0; m < 4; ++m) _Pragma("unroll") for (int n = 0; n < 2; ++n) _Pragma("unroll") for (int j = 0; j < 4; ++j) { \
        const int row = brow + ai * 128 + wr * 64 + m * 16 + fq * 4 + j; const int cw = wc * 32 + n * 16 + fr; \
        const float v0 = acc[ai][0][m][n][j]; const float v1 = acc[ai][1][m][n][j]; BODY } }
      switch (ph) {
        case 2: {
          if (pn < 4) { u16* U2X = (u16*)(p->ws + OFF_C);
            EPI_ALL({ U2X[(size_t)(col >> 4) * GS + (size_t)(row >> 4) * 512 + (row & 15) * 16 + (col & 15)] = f2bf(v); }) }
          else if (pn < 18) { h16* ZRW = (h16*)(p->ws + OFF_D);
            EPI_ALL({ ZRW[(size_t)row * ZRWP + (col - 1024)] = (h16)v; }) }
          else { u16* GT = (u16*)(p->ws + OFF_E);
            EPI_ALL({ GT[(size_t)row * 4096 + (col - 4608)] = f2bf(sigm(v)); }) }
        } break;
        case 3: { float* XLOC = p->out;
          EPI_ALL({ if (row < 544) XLOC[((size_t)e0 * 544 + row) * 256 + col] = v; }) } break;
        case 4: {
          const int sec = pn >> 2;
          h16* dst = (h16*)(p->ws + OFF_FX) + (size_t)sec * NTOK * 1024;
          if (sec < 2) { const float* w0 = p->in[I_W0] + sec * 1024;
            EPI_ALL({ const int c = col & 1023; dst[(size_t)row * 1024 + c] = (h16)(0.6065306597126334f * sigm(w0[c] + v)); }) }
          else if (sec < 4) { const float* a0 = p->in[I_A0] + (sec - 2) * 1024;
            EPI_ALL({ const int c = col & 1023; dst[(size_t)row * 1024 + c] = (h16)sigm(a0[c] + v); }) }
          else { EPI_ALL({ const int c = col & 1023; dst[(size_t)row * 1024 + c] = (h16)v; }) }
        } break;
        case 5: { u16* YS = (u16*)(p->ws + OFF_D + 33554432);
          EPI_ALL({ YS[(size_t)(row * 16 + (col >> 4)) * 1024 + e0 * 16 + (col & 15)] = f2bf(gelu_tanh(v)); }) } break;
        case 7: {
          const u16* GT = (const u16*)(p->ws + OFF_E); float* M1 = p->out;
          float* T0 = (float*)smem; float* T1 = (float*)smem + 128 * 132;
          const int c4 = te & 31, r0 = te >> 5;
          if (sub < 2) {
#pragma unroll
            for (int ai = 0; ai < 2; ++ai) {
              QWRITE(T0, ai, 0); QWRITE(T1, ai, 1);
              __syncthreads();
              const int cm_ = pn * 256 + sub * 128 + c4 * 4;
              uint2 gg[8];
#pragma unroll
              for (int i = 0; i < 8; ++i) gg[i] = *(const uint2*)(GT + (size_t)(brow + ai * 128 + r0 + i * 16) * 4096 + cm_);
#pragma unroll
              for (int i = 0; i < 8; ++i) {
                const int r = r0 + i * 16;
                const float4 a = *(const float4*)(T0 + r * 132 + c4 * 4), bq = *(const float4*)(T1 + r * 132 + c4 * 4);
                float4 o;
                o.x = a.x * sigm(bq.x) * bf2f((u16)(gg[i].x & 0xffffu)); o.y = a.y * sigm(bq.y) * bf2f((u16)(gg[i].x >> 16));
                o.z = a.z * sigm(bq.z) * bf2f((u16)(gg[i].y & 0xffffu)); o.w = a.w * sigm(bq.w) * bf2f((u16)(gg[i].y >> 16));
                *(float4*)(M1 + (size_t)(brow + ai * 128 + r) * 2048 + cm_) = o;
              }
              __syncthreads();
            }
          } else { u16* MG = (u16*)(p->ws + OFF_B);
#pragma unroll
            for (int ai = 0; ai < 2; ++ai)
#pragma unroll
              for (int bj = 0; bj < 2; ++bj) {
                QWRITE(T0, ai, bj);
                __syncthreads();
                const int col = bcol + bj * 128 + c4 * 4;
                uint2 gg[8]; float4 mm[8];
#pragma unroll
                for (int i = 0; i < 8; ++i) { const size_t row = (size_t)(brow + ai * 128 + r0 + i * 16);
                  gg[i] = *(const uint2*)(GT + row * 4096 + 2048 + col); mm[i] = *(const float4*)(M1 + row * 2048 + col); }
#pragma unroll
                for (int i = 0; i < 8; ++i) {
                  const int r = r0 + i * 16;
                  const float4 a = *(const float4*)(T0 + r * 132 + c4 * 4);
                  const float o0 = mm[i].x + bf2f((u16)(gg[i].x & 0xffffu)) * a.x, o1 = mm[i].y + bf2f((u16)(gg[i].x >> 16)) * a.y;
                  const float o2 = mm[i].z + bf2f((u16)(gg[i].y & 0xffffu)) * a.z, o3 = mm[i].w + bf2f((u16)(gg[i].y >> 16)) * a.w;
                  uint2 o; o.x = (unsigned)f2bf(o0) | ((unsigned)f2bf(o1) << 16); o.y = (unsigned)f2bf(o2) | ((unsigned)f2bf(o3) << 16);
                  *(uint2*)(MG + (size_t)(brow + ai * 128 + r) * 2048 + col) = o;
                }
                __syncthreads();
              }
          }
        } break;
        case 8: { const float* MOD = (const float*)(p->ws + OFF_MOD); const float* ab = p->in[I_ADAB]; const float* x = p->in[I_X];
          float* T0 = (float*)smem; const int c4 = te & 31, r0 = te >> 5;
#pragma unroll
          for (int ai = 0; ai < 2; ++ai)
#pragma unroll
            for (int bj = 0; bj < 2; ++bj) {
              QWRITE(T0, ai, bj);
              __syncthreads();
              const int col = bcol + bj * 128 + c4 * 4;
              const float4 ga = *(const float4*)(MOD + (brow >> 12) * 12288 + 4096 + col), gb = *(const float4*)(ab + 4096 + col);
              float4 xx[8];
#pragma unroll
              for (int i = 0; i < 8; ++i) xx[i] = *(const float4*)(x + (size_t)(brow + ai * 128 + r0 + i * 16) * 2048 + col);
#pragma unroll
              for (int i = 0; i < 8; ++i) {
                const int r = r0 + i * 16;
                const float4 a = *(const float4*)(T0 + r * 132 + c4 * 4);
                float4 o; o.x = xx[i].x + (ga.x + gb.x) * a.x; o.y = xx[i].y + (ga.y + gb.y) * a.y; o.z = xx[i].z + (ga.z + gb.z) * a.z; o.w = xx[i].w + (ga.w + gb.w) * a.w;
                *(float4*)(p->out + (size_t)(brow + ai * 128 + r) * 2048 + col) = o;
              }
              __syncthreads();
            }
        } break;
        case 10: { u16* ACT = (u16*)(p->ws + OFF_C);
          EPI_HALF({ ACT[(size_t)row * DFF + pn * 128 + cw] = f2bf(silu_(v0) * v1); }) } break;
        default: { const float* MOD = (const float*)(p->ws + OFF_MOD); const float* ab = p->in[I_ADAB];
          float* T0 = (float*)smem; const int c4 = te & 31, r0 = te >> 5;
#pragma unroll
          for (int ai = 0; ai < 2; ++ai)
#pragma unroll
            for (int bj = 0; bj < 2; ++bj) {
              QWRITE(T0, ai, bj);
              __syncthreads();
              const int col = bcol + bj * 128 + c4 * 4;
              const float4 ga = *(const float4*)(MOD + (brow >> 12) * 12288 + 10240 + col), gb = *(const float4*)(ab + 10240 + col);
              float4 xx[8];
#pragma unroll
              for (int i = 0; i < 8; ++i) xx[i] = *(const float4*)(p->out + (size_t)(brow + ai * 128 + r0 + i * 16) * 2048 + col);
#pragma unroll
              for (int i = 0; i < 8; ++i) {
                const int r = r0 + i * 16;
                const float4 a = *(const float4*)(T0 + r * 132 + c4 * 4);
                float4 o; o.x = xx[i].x + (ga.x + gb.x) * a.x; o.y = xx[i].y + (ga.y + gb.y) * a.y; o.z = xx[i].z + (ga.z + gb.z) * a.z; o.w = xx[i].w + (ga.w + gb.w) * a.w;
                *(float4*)(p->out + (size_t)(brow + ai * 128 + r) * 2048 + col) = o;
              }
              __syncthreads();
            }
        } break;
      }
     }
    }
    if (ph == 2 && G > 100 && bid >= 100) { __syncthreads(); conv_run<2>(p, wv * 64 + lane_id_opaque(), smem, bid - 100, G - 100); }
  }
}

__global__ void __launch_bounds__(NTHR, 2) mega(Params p_arg) {
  extern __shared__ __attribute__((aligned(16))) unsigned char smem[];
  const int G = gridDim.x;
  const int ph_lo = p_arg.ph_lo, ph_hi = p_arg.ph_hi;
  const int wv = __builtin_amdgcn_readfirstlane((int)threadIdx.x >> 6);
  const unsigned xcc = xb_xcc_id();
  unsigned nloc = 1u, nx = 1u;
  if (ph_hi > 1000) cg::this_grid().sync();
  if (ph_hi - ph_lo > 1) {
    unsigned* bar = (unsigned*)(p_arg.ws + OFF_XB);
    if (threadIdx.x == 0) (void)xb_add(&bar[XB_XCNT(xcc)], 1u);
  }
#define PHASE(k) if (ph_lo <= (k) && (k) < ph_hi) { \
    const int tid = wv * 64 + lane_id_opaque(); \
    int bid = blockIdx.x; asm volatile("" : "+s"(bid)); \
    KP p = (KP)__builtin_amdgcn_kernarg_segment_ptr(); asm volatile("" : "+s"(p)); \
    run_phase<k>(p, wv, tid, bid, G, smem); \
    if ((k) + 1 < ph_hi) { if ((k) == 0) {   \
        unsigned* bar = (unsigned*)(p->ws + OFF_XB); \
        if (wv * 64 + lane_id_opaque() == 0) { for (;;) { unsigned sum = 0u; _Pragma("unroll") for (unsigned j = 0; j < 16; ++j) sum += xb_ld(&bar[XB_XCNT(j)]); if (sum == (unsigned)G) break; __builtin_amdgcn_s_sleep(1); } } \
        __syncthreads(); \
        unsigned mine = 0u, cnt = 0u; \
        _Pragma("unroll") for (unsigned j = 0; j < 16; ++j) { const unsigned c = xb_ld(&bar[XB_XCNT(j)]); cnt += (c > 0u) ? 1u : 0u; mine = (j == xcc) ? c : mine; } \
        nloc = (unsigned)__builtin_amdgcn_readfirstlane((int)(mine > 0u ? mine : 1u)); nx = (unsigned)__builtin_amdgcn_readfirstlane((int)(cnt > 0u ? cnt : 1u)); } \
      grid_barrier((unsigned*)(p->ws + OFF_XB), xcc, nloc, nx, wv * 64 + lane_id_opaque()); } }
  PHASE(0) PHASE(1) PHASE(2) PHASE(3) PHASE(4) PHASE(5) PHASE(6) PHASE(7) PHASE(8) PHASE(9) PHASE(10) PHASE(11) PHASE(12)
}

extern "C" void kernel_launch(void* const* d_in, const int* in_sizes, int n_in, void* d_out, int out_size, void* d_ws, size_t ws_size,
                              hipStream_t stream) {
  constexpr int LDS_BYTES = 159744;
  static int grid = 0;
  if (grid == 0) {
    if (n_in != 34 || ws_size < WS_END) { fprintf(stderr, "kernel_launch: bad args n_in %d ws %zu (need %zu)\n", n_in, ws_size, (size_t)WS_END); grid = -1; return; }
    int dev = 0, cus = 0, per_cu = 0;
    hipGetDevice(&dev);
    hipDeviceGetAttribute(&cus, hipDeviceAttributeMultiprocessorCount, dev);
    if (hipFuncSetAttribute((const void*)mega, hipFuncAttributeMaxDynamicSharedMemorySize, LDS_BYTES) != hipSuccess) { fprintf(stderr, "hipFuncSetAttribute failed\n"); grid = -1; return; }
    hipOccupancyMaxActiveBlocksPerMultiprocessor(&per_cu, (const void*)mega, NTHR, LDS_BYTES);
    (void)hipGetLastError();
    if (per_cu < 1) per_cu = 1;
    grid = cus;
    fprintf(stderr, "kernel_launch: cus %d per_cu %d grid %d ws %zu\n", cus, per_cu, grid, ws_size);
  }
  if (grid < 0) return;
  hipMemsetAsync((char*)d_ws + OFF_XB, 0, 16384, stream);
  Params p{};
  for (int i = 0; i < 34; ++i) p.in[i] = (const float*)d_in[i];
  p.out = (float*)d_out; p.ws = (unsigned char*)d_ws;
#if ONE_LAUNCH
  p.ph_lo = 0; p.ph_hi = 13;
  void* args[] = {&p};
  hipError_t e = hipLaunchCooperativeKernel((const void*)mega, dim3(grid), dim3(NTHR), args, LDS_BYTES, stream);
  if (e != hipSuccess) fprintf(stderr, "cooperative launch failed: %s\n", hipGetErrorString(e));
#else
  for (int ph = 0; ph < 13; ++ph) {
    p.ph_lo = ph; p.ph_hi = ph + 1;
    hipLaunchKernelGGL(mega, dim3(grid), dim3(NTHR), LDS_BYTES, stream, p);
  }
#endif
}
```

```cpp
#include <hip/hip_runtime.h>
#include <hip/hip_cooperative_groups.h>
#include <cstdio>
namespace cg = cooperative_groups;

#ifndef ONE_LAUNCH
#define ONE_LAUNCH 1
#endif

typedef unsigned short u16;
typedef _Float16 h16;
using bf16x8 = __attribute__((ext_vector_type(8))) short;
using f32x4 = __attribute__((ext_vector_type(4))) float;
using h16x2 = __attribute__((ext_vector_type(2))) _Float16;
using h16x8 = __attribute__((ext_vector_type(8))) _Float16;
#define DEVI __device__ __forceinline__

constexpr int NLAT = 8192, NTOK = 8704;
constexpr int ZRWP = 3584;
constexpr int DFF = 5632;
constexpr int GS = 544 * 512;
constexpr int NTHR = 512;

constexpr size_t ARRB = 17825792;
constexpr size_t OFF_MOD = 0;
constexpr size_t OFF_BAR = 147456;
constexpr size_t OFF_GLUT = 147456 + 256;
constexpr size_t OFF_RWPT = OFF_GLUT + 8388608;
constexpr size_t OFF_WOT = OFF_RWPT + 4194304;
constexpr size_t OFF_LORAT = OFF_WOT + 8388608;
constexpr size_t OFF_BMAT = OFF_LORAT + 3932160;
constexpr size_t OFF_KC = OFF_BMAT + 8388608;
constexpr size_t OFF_LA = OFF_KC + 16777216;
constexpr size_t OFF_A = OFF_LA + 6684672;
constexpr size_t OFF_B = OFF_A + 35651584;
constexpr size_t OFF_FX = OFF_B + 35651584;
constexpr size_t OFF_C = OFF_FX + 89128960;
constexpr size_t OFF_D = OFF_C + 35880960;
constexpr size_t OFF_E = OFF_D + 62390272;
constexpr size_t OFF_XB = OFF_E + 67108864;
constexpr size_t OFF_W2T = OFF_XB + 16384;
constexpr size_t OFF_W13A = OFF_W2T + 23068672;
constexpr int W13A_TILES = 19;
constexpr size_t WS_END = OFF_W13A + (size_t)W13A_TILES * 256 * 2048 * 2;

struct Params {
  const float* in[34];
  float* out;
  unsigned char* ws;
  int ph_lo, ph_hi;
};
typedef const __attribute__((address_space(4))) Params* KP;

enum { I_X = 0, I_C, I_CTX, I_CCTX, I_ADAW, I_ADAB, I_N1W, I_WIN, I_MU, I_SARE, I_SAIM, I_SLDT, I_SBRE, I_SBIM, I_SCRE, I_SCIM,
       I_SD, I_GLUW, I_W0, I_W2, I_A0, I_A2, I_G2, I_KK, I_KA, I_RK, I_LNW, I_LNB, I_RWP, I_WO, I_N2W, I_W13, I_FW2, I_NF };

DEVI float4 ldnt4(const float* q) { f32x4 v = __builtin_nontemporal_load((const f32x4*)q); return make_float4(v[0], v[1], v[2], v[3]); }
DEVI int lane_id_opaque() { int r; asm volatile("v_mbcnt_lo_u32_b32 %0, -1, 0\n\tv_mbcnt_hi_u32_b32 %0, -1, %0" : "=v"(r)); return r; }
DEVI u16 f2bf(float f) { unsigned u = __float_as_uint(f); u += 0x7fffu + ((u >> 16) & 1u); return (u16)(u >> 16); }
DEVI float bf2f(u16 h) { return __uint_as_float(((unsigned)h) << 16); }
DEVI float sigm(float x) { return 1.f / (1.f + __expf(-x)); }
DEVI float tanh_(float x) { float e = __expf(2.f * x); return 1.f - 2.f / (1.f + e); }
DEVI float gelu_tanh(float x) { float u = 0.7978845608028654f * (x + 0.044715f * x * x * x); return 0.5f * x * (1.f + tanh_(u)); }
DEVI float silu_(float x) { return x / (1.f + __expf(-x)); }
template <int CTRL> DEVI float dppf(float x) {
  return __builtin_bit_cast(float, __builtin_amdgcn_update_dpp(0, __builtin_bit_cast(int, x), CTRL, 0xF, 0xF, false));
}
DEVI float red16(float x) { x += dppf<0xB1>(x); x += dppf<0x4E>(x); x += dppf<0x141>(x); x += dppf<0x140>(x); return x; }
DEVI float red32(float x) { x = red16(x); x += __shfl_xor(x, 16); return x; }
DEVI float red64(float x) { x = red16(x); x += __shfl_xor(x, 16); x += __shfl_xor(x, 32); return x; }
DEVI void cpow(float are, float aim, float dt, float tau, float& re, float& im) {
  float mag = expf(tau * are * dt);
  float th = tau * aim * dt;
  float n = rintf(th * 0.15915494309189535f);
  float r = fmaf(-n, 6.28125f, th);
  r = fmaf(-n, 1.9353071795864769e-3f, r);
  re = mag * cosf(r); im = mag * sinf(r);
}

constexpr int BM = 256, BK = 64, HALF = 128, HT = HALF * BK;
DEVI int lds_byte(int r, int c) {
  int st = (r >> 4) * 2 + (c >> 5), rr = r & 15, cc = c & 31, ob = rr * 64 + cc * 2;
  return st * 1024 + (ob ^ (((ob >> 9) & 1) << 5));
}
DEVI void stage_rc(int b, int& R, int& C) {
  int st = b / 1024, sb = b % 1024, swz = sb ^ (((sb >> 9) & 1) << 5);
  R = (st >> 1) * 16 + swz / 64; C = (st & 1) * 32 + (swz % 64) / 2;
}

DEVI void gemm_core(const int wv_in, u16* shm, const u16* A, long lda, const u16* Bt, long ldb, int K, int brow, int bcol, f32x4 (&acc)[2][2][4][2]) {
#define SA(b, h) (shm + ((b) * 2 + (h)) * HT)
#define SB(b, h) (shm + (4 + (b) * 2 + (h)) * HT)
#define STAGE(P, BASE, LD, OFFS, br, kt) do { const char* _ub = (const char*)((BASE) + (long)(br) * (LD) + (long)(kt) * BK); \
    _Pragma("unroll") for (int _i = 0; _i < 2; ++_i) { \
      __builtin_amdgcn_global_load_lds((const unsigned*)(_ub + OFFS[_i]), \
        (__attribute__((address_space(3))) unsigned*)((char*)(P) + wv_s * 1024 + _i * 8192), 16, 0, 0); } } while (0)
#define LDA(dst, b, h) _Pragma("unroll") for (int m = 0; m < 4; ++m) _Pragma("unroll") for (int k = 0; k < 2; ++k) \
    dst[m][k] = *reinterpret_cast<const bf16x8*>((char*)SA(b, h) + lds_byte(wr * 64 + m * 16 + fr, k * 32 + fq * 8))
#define LDB(dst, b, h) _Pragma("unroll") for (int n = 0; n < 2; ++n) _Pragma("unroll") for (int k = 0; k < 2; ++k) \
    dst[n][k] = *reinterpret_cast<const bf16x8*>((char*)SB(b, h) + lds_byte(wc * 32 + n * 16 + fr, k * 32 + fq * 8))
#define MMA(ai, bj, At, Bq) do { __builtin_amdgcn_s_setprio(1); \
    _Pragma("unroll") for (int m = 0; m < 4; ++m) _Pragma("unroll") for (int n = 0; n < 2; ++n) _Pragma("unroll") for (int k = 0; k < 2; ++k) \
      acc[ai][bj][m][n] = __builtin_amdgcn_mfma_f32_16x16x32_bf16(At[m][k], Bq[n][k], acc[ai][bj][m][n], 0, 0, 0); \
    __builtin_amdgcn_s_setprio(0); } while (0)
#define WAIT_V(n) asm volatile("s_waitcnt vmcnt(" #n ")" ::: "memory")
#define WAIT_L(n) asm volatile("s_waitcnt lgkmcnt(" #n ")" ::: "memory")
#define BAR __builtin_amdgcn_s_barrier()
#define SCHED __builtin_amdgcn_sched_barrier(0)
  const int tid = wv_in * 64 + lane_id_opaque();
  const int wv_s = wv_in;
  const int wid = tid >> 6, lane = tid & 63, wr = wid >> 2, wc = wid & 3, fr = lane & 15, fq = lane >> 4;
#pragma unroll
  for (int a = 0; a < 2; ++a)
#pragma unroll
    for (int b = 0; b < 2; ++b)
#pragma unroll
      for (int m = 0; m < 4; ++m)
#pragma unroll
        for (int n = 0; n < 2; ++n) acc[a][b][m][n] = (f32x4){0.f, 0.f, 0.f, 0.f};
  bf16x8 At[4][2], B0[2][2], B1[2][2];
  const int nt = K / BK;
  unsigned offA[2], offB[2];
#pragma unroll
  for (int i = 0; i < 2; ++i) { int r_, c_; stage_rc(tid * 16 + i * 8192, r_, c_); offA[i] = (unsigned)(r_ * (int)lda + c_) * 2u; offB[i] = (unsigned)(r_ * (int)ldb + c_) * 2u; }
  WAIT_V(0);
  STAGE(SB(0, 0), Bt, ldb, offB, bcol, 0); STAGE(SA(0, 0), A, lda, offA, brow, 0);
  STAGE(SB(0, 1), Bt, ldb, offB, bcol + HALF, 0); STAGE(SA(0, 1), A, lda, offA, brow + HALF, 0);
  if (wr == 1) BAR;
  WAIT_V(4); BAR;
  STAGE(SB(1, 0), Bt, ldb, offB, bcol, 1); STAGE(SA(1, 0), A, lda, offA, brow, 1); STAGE(SB(1, 1), Bt, ldb, offB, bcol + HALF, 1);
  WAIT_V(6); BAR;
  for (int t = 0; t < nt - 2; t += 2) {
    LDB(B0, 0, 0); SCHED; LDA(At, 0, 0); STAGE(SA(1, 1), A, lda, offA, brow + HALF, t + 1);
    WAIT_L(8); BAR; WAIT_L(0); MMA(0, 0, At, B0); BAR; SCHED;
    LDB(B1, 0, 1); STAGE(SB(0, 0), Bt, ldb, offB, bcol, t + 2);
    BAR; WAIT_L(0); MMA(0, 1, At, B1); BAR;
    LDA(At, 0, 1); STAGE(SA(0, 0), A, lda, offA, brow, t + 2);
    BAR; WAIT_L(0); MMA(1, 0, At, B0); BAR; SCHED;
    STAGE(SB(0, 1), Bt, ldb, offB, bcol + HALF, t + 2);
    WAIT_V(6); BAR; MMA(1, 1, At, B1); BAR;
    LDB(B0, 1, 0); SCHED; LDA(At, 1, 0); STAGE(SA(0, 1), A, lda, offA, brow + HALF, t + 2);
    WAIT_L(8); BAR; WAIT_L(0); MMA(0, 0, At, B0); BAR; SCHED;
    LDB(B1, 1, 1); STAGE(SB(1, 0), Bt, ldb, offB, bcol, t + 3);
    BAR; WAIT_L(0); MMA(0, 1, At, B1); BAR;
    LDA(At, 1, 1); STAGE(SA(1, 0), A, lda, offA, brow, t + 3);
    BAR; WAIT_L(0); MMA(1, 0, At, B0); BAR; SCHED;
    STAGE(SB(1, 1), Bt, ldb, offB, bcol + HALF, t + 3);
    WAIT_V(6); BAR; MMA(1, 1, At, B1); BAR;
  }
  { LDB(B0, 0, 0); LDA(At, 0, 0); STAGE(SA(1, 1), A, lda, offA, brow + HALF, nt - 1);
    BAR; WAIT_L(0); MMA(0, 0, At, B0); BAR;
    LDB(B1, 0, 1); BAR; WAIT_L(0); MMA(0, 1, At, B1); BAR;
    LDA(At, 0, 1); WAIT_V(4); BAR; WAIT_L(0); MMA(1, 0, At, B0); MMA(1, 1, At, B1); BAR; }
  { LDB(B0, 1, 0); LDA(At, 1, 0); WAIT_V(2); BAR; WAIT_L(0); MMA(0, 0, At, B0); BAR;
    LDB(B1, 1, 1); WAIT_V(0); BAR; WAIT_L(0); MMA(0, 1, At, B1); BAR;
    LDA(At, 1, 1); BAR; WAIT_L(0); MMA(1, 0, At, B0); MMA(1, 1, At, B1); BAR; }
  if (wr == 0) BAR;
}

DEVI void tile_map(int nM, int nN, int idx, int& pm, int& pn) {
  int nwg = nM * nN; int q = nwg / 8, r = nwg % 8, xcd = idx % 8, off = idx / 8;
  int w = (xcd < r ? xcd * (q + 1) : r * (q + 1) + (xcd - r) * q) + off;
  int nig = 8 * nN, gid = w / nig, fm = gid * 8, gsz = min(nM - fm, 8);
  pm = fm + ((w % nig) % gsz); pn = (w % nig) / gsz;
}

struct ConvJob { const float* src; long ld; u16* dst; long ldd; int zero; };
DEVI void conv_load(const int tid, const ConvJob& j, float4 (&v)[4]) {
  const int rr2 = tid >> 4, cc = (tid & 15) * 4;
  const float* s0 = j.src + (long)(2 * rr2) * j.ld + cc;
  v[0] = ldnt4(s0); v[1] = ldnt4(s0 + j.ld);
  v[2] = ldnt4(s0 + 64); v[3] = ldnt4(s0 + j.ld + 64);
}
DEVI unsigned pk2(float a, float b) { return (unsigned)f2bf(a) | ((unsigned)f2bf(b) << 16); }
DEVI void conv_store(const int tid, unsigned char* smem, const ConvJob& j, const float4 (&v)[4]) {
  unsigned* T = (unsigned*)smem;
  const int rr2 = tid >> 4, cc = (tid & 15) * 4;
  const unsigned zm = j.zero ? 0u : 0xffffffffu;
#define pk2(a, b) (pk2(a, b) & zm)
  T[(cc + 0) * 36 + rr2] = pk2(v[0].x, v[1].x); T[(cc + 1) * 36 + rr2] = pk2(v[0].y, v[1].y);
  T[(cc + 2) * 36 + rr2] = pk2(v[0].z, v[1].z); T[(cc + 3) * 36 + rr2] = pk2(v[0].w, v[1].w);
  T[(cc + 64) * 36 + rr2] = pk2(v[2].x, v[3].x); T[(cc + 65) * 36 + rr2] = pk2(v[2].y, v[3].y);
  T[(cc + 66) * 36 + rr2] = pk2(v[2].z, v[3].z); T[(cc + 67) * 36 + rr2] = pk2(v[2].w, v[3].w);
#undef pk2
  __syncthreads();
#pragma unroll
  for (int h = 0; h < 2; ++h) {
    int n = (tid >> 3) + h * 64, kc = (tid & 7) * 4;
    uint4 o = *(const uint4*)(T + n * 36 + kc);
    *(uint4*)(j.dst + (long)n * j.ldd + kc * 2) = o;
  }
  __syncthreads();
}
DEVI ConvJob conv_job0(KP p, int idx) {
  ConvJob j; j.zero = 0;
  if (idx < 2176) { int nt = idx % 68, kt = idx / 68, n0 = nt * 128; j.zero = (n0 >= 4480 && n0 < 4608); int c0 = n0 < 4480 ? n0 : (j.zero ? 0 : n0 - 128);
    j.src = p->in[I_WIN] + (long)(kt * 64) * 8576 + c0; j.ld = 8576; j.dst = (u16*)(p->ws + OFF_A) + (long)n0 * 2048 + kt * 64; j.ldd = 2048; }
  else { int q = idx - 2176; j.ld = 1024; j.ldd = 384;
    if (q < 32) { int sec = q >> 3, nt = q & 7, d = sec & 1;
      j.src = (sec < 2 ? p->in[I_W2] : p->in[I_A2]) + (long)d * 64 * 1024 + nt * 128; j.dst = (u16*)(p->ws + OFF_LORAT) + (long)(sec * 1024 + nt * 128) * 384 + sec * 64; }
    else { int qq = q - 32, kt = qq >> 3, nt = qq & 7;
      j.src = p->in[I_G2] + (long)(kt * 64) * 1024 + nt * 128; j.dst = (u16*)(p->ws + OFF_LORAT) + (long)(4096 + nt * 128) * 384 + 256 + kt * 64; } }
  return j;
}
DEVI ConvJob conv_job7(KP p, int idx) {
  ConvJob j; j.zero = 0;
  { int kt = idx & 31, nt = (idx >> 5) + 2 * W13A_TILES, n0 = nt * 128, t = n0 >> 8, wi = n0 & 255; int c0 = wi < 128 ? t * 128 : DFF + t * 128;
    j.src = p->in[I_W13] + (long)(kt * 64) * (2 * DFF) + c0; j.ld = 2 * DFF; j.dst = (u16*)(p->ws + OFF_FX) + (long)n0 * 2048 + kt * 64; j.ldd = 2048; }
  return j;
}
DEVI ConvJob conv_job2(KP p, int idx) {
  ConvJob j; j.zero = 0;
  { int kt = idx % 88, nt = idx / 88, n0 = nt * 128;
    j.src = p->in[I_FW2] + (long)(kt * 64) * 2048 + n0; j.ld = 2048; j.dst = (u16*)(p->ws + OFF_W2T) + (long)n0 * DFF + kt * 64; j.ldd = DFF; }
  return j;
}
template <int WHICH>
DEVI void conv_run(KP p, const int tid, unsigned char* smem, int bid, int G) {
  const int njobs = WHICH == 0 ? 2224 : (WHICH == 1 ? (88 - 2 * W13A_TILES) * 32 : 1408);
  int idx = bid;
  if (idx >= njobs) return;
#define CJOB(i) (WHICH == 0 ? conv_job0(p, (i)) : (WHICH == 1 ? conv_job7(p, (i)) : conv_job2(p, (i))))
  ConvJob ja = CJOB(idx); float4 va[4]; conv_load(tid, ja, va);
  for (;;) {
    const int i1 = idx + G; const bool h1 = i1 < njobs;
    float4 vb[4];
    const ConvJob jb = CJOB(h1 ? i1 : idx); conv_load(tid, jb, vb);
    conv_store(tid, smem, ja, va);
    if (!h1) break;
    const int i2 = i1 + G; const bool h2 = i2 < njobs;
    ja = CJOB(h2 ? i2 : i1); conv_load(tid, ja, va);
    conv_store(tid, smem, jb, vb);
    if (!h2) break;
    idx = i2;
  }
#undef CJOB
}

DEVI void row_norm_phase(KP p, const int tid, int mode, int bid, int G) {
  const int lane = tid & 63, wave = tid >> 6;
  const float* MOD = (const float*)(p->ws + OFF_MOD);
  const float* adab = p->in[I_ADAB];
  const int nrows = (mode == 0) ? NTOK : NLAT;
  for (int r = bid * 8 + wave; r < nrows; r += G * 8) {
    const float* src; int mrow;
    if (mode == 0) { if (r < NLAT) { src = p->in[I_X] + (size_t)r * 2048; mrow = r >> 12; } else { src = p->in[I_CTX] + (size_t)(r - NLAT) * 2048; mrow = 2; } }
    else { src = p->out + (size_t)r * 2048; mrow = r >> 12; }
    float4 v[8]; float ss = 0.f;
#pragma unroll
    for (int i = 0; i < 8; ++i) { v[i] = ldnt4(src + (i * 64 + lane) * 4); ss += v[i].x * v[i].x + v[i].y * v[i].y + v[i].z * v[i].z + v[i].w * v[i].w; }
    ss = red64(ss);
    const float rs = rsqrtf(ss * (1.f / 2048.f) + 1e-6f);
    const float* nw = p->in[mode == 0 ? I_N1W : (mode == 1 ? I_N2W : I_NF)];
    const int shoff = (mode == 0) ? 0 : 6144, scoff = (mode == 0) ? 2048 : 8192;
    u16* dstb = (u16*)(p->ws + (mode == 0 ? OFF_B : OFF_A)) + (size_t)r * 2048;
#pragma unroll
    for (int i = 0; i < 8; ++i) {
      int c = (i * 64 + lane) * 4;
      float4 w4 = *(const float4*)(nw + c);
      float y0 = v[i].x * rs * w4.x, y1 = v[i].y * rs * w4.y, y2 = v[i].z * rs * w4.z, y3 = v[i].w * rs * w4.w;
      if (mode == 2) { *(float4*)(p->out + (size_t)r * 2048 + c) = make_float4(y0, y1, y2, y3); }
      else {
        float4 sh = *(const float4*)(MOD + mrow * 12288 + shoff + c), shb = *(const float4*)(adab + shoff + c);
        float4 sc = *(const float4*)(MOD + mrow * 12288 + scoff + c), scb = *(const float4*)(adab + scoff + c);
        y0 = y0 * (1.f + sc.x + scb.x) + sh.x + shb.x; y1 = y1 * (1.f + sc.y + scb.y) + sh.y + shb.y;
        y2 = y2 * (1.f + sc.z + scb.z) + sh.z + shb.z; y3 = y3 * (1.f + sc.w + scb.w) + sh.w + shb.w;
        uint2 o; o.x = (unsigned)f2bf(y0) | ((unsigned)f2bf(y1) << 16); o.y = (unsigned)f2bf(y2) | ((unsigned)f2bf(y3) << 16);
        *(uint2*)(dstb + c) = o;
      }
    }
  }
}

DEVI void phase0(KP p, const int tid, unsigned char* smem, int bid, int G) {
  {
    float* sv = (float*)smem;
    float* red = (float*)(smem + 24576);
    for (int i = tid; i < 3 * 2048; i += NTHR) {
      int j = i >> 11, k = i & 2047;
      float cv = (j < 2) ? p->in[I_C][j * 2048 + k] : p->in[I_CCTX][k];
      sv[i] = silu_(cv);
    }
    __syncthreads();
    float* MOD = (float*)(p->ws + OFF_MOD);
    const float* aw = p->in[I_ADAW];
    for (int cb = bid; cb < 256; cb += G) {
      const int cgq = tid % 12, ksl = tid / 12;
      float a0[4] = {0, 0, 0, 0}, a1[4] = {0, 0, 0, 0}, a2[4] = {0, 0, 0, 0};
      if (tid < 504) {
        const float* wp = aw + cb * 48 + cgq * 4;
#pragma unroll 7
        for (int k = ksl; k < 2048; k += 42) {
          float4 wv = ldnt4(wp + (size_t)k * 12288);
          float s0 = sv[k], s1 = sv[2048 + k], s2 = sv[4096 + k];
          a0[0] += s0 * wv.x; a0[1] += s0 * wv.y; a0[2] += s0 * wv.z; a0[3] += s0 * wv.w;
          a1[0] += s1 * wv.x; a1[1] += s1 * wv.y; a1[2] += s1 * wv.z; a1[3] += s1 * wv.w;
          a2[0] += s2 * wv.x; a2[1] += s2 * wv.y; a2[2] += s2 * wv.z; a2[3] += s2 * wv.w;
        }
        float* rp = red + (ksl * 12 + cgq) * 12;
#pragma unroll
        for (int e = 0; e < 4; ++e) { rp[e] = a0[e]; rp[4 + e] = a1[e]; rp[8 + e] = a2[e]; }
      }
      __syncthreads();
      if (tid < 144) {
        const int j = tid / 48, c = tid % 48;
        float sum = 0.f;
        for (int q = 0; q < 42; ++q) sum += red[(q * 12 + (c >> 2)) * 12 + j * 4 + (c & 3)];
        MOD[j * 12288 + cb * 48 + c] = sum;
      }
      __syncthreads();
    }
  }
  for (int g = G - 1 - bid; g < 64 && g >= 0; g += G) {
    float2* lamp = (float2*)smem;
    float2* bb = (float2*)(smem + 17408);
    float2* cm = (float2*)(smem + 17408 + 16384);
    float* ktab = (float*)(smem + 17408 + 32768);
    for (int i = tid; i < 2 * 17 * 64; i += NTHR) {
      int d = i / (17 * 64), tau = (i / 64) % 17, pp = i & 63;
      float are = p->in[I_SARE][(d * 64 + g) * 64 + pp], aim = p->in[I_SAIM][(d * 64 + g) * 64 + pp];
      float dt = expf(p->in[I_SLDT][d * 64 + g]);
      float re, im; cpow(are, aim, dt, (float)tau, re, im);
      lamp[i] = make_float2(re, im);
    }
    for (int i = tid; i < 2048; i += NTHR) {
      int d = i >> 10, pp = (i >> 4) & 63, h = i & 15;
      float are = p->in[I_SARE][(d * 64 + g) * 64 + pp], aim = p->in[I_SAIM][(d * 64 + g) * 64 + pp];
      float dt = expf(p->in[I_SLDT][d * 64 + g]);
      float lr, li; cpow(are, aim, dt, 1.f, lr, li);
      float nr = lr - 1.f, ni = li, den = 1.f / (are * are + aim * aim);
      float qr = (nr * are + ni * aim) * den, qi = (ni * are - nr * aim) * den;
      float br = p->in[I_SBRE][((size_t)(d * 64 + g) * 64 + pp) * 16 + h], bi = p->in[I_SBIM][((size_t)(d * 64 + g) * 64 + pp) * 16 + h];
      bb[i] = make_float2(qr * br - qi * bi, qr * bi + qi * br);
      int h2 = (i >> 6) & 15, p2 = i & 63;
      cm[i] = make_float2(p->in[I_SCRE][((size_t)(d * 64 + g) * 16 + h2) * 64 + p2], p->in[I_SCIM][((size_t)(d * 64 + g) * 16 + h2) * 64 + p2]);
    }
    __syncthreads();
    {
      const int d = tid >> 8, h = (tid >> 4) & 15, h2 = tid & 15;
      float acc[16];
#pragma unroll
      for (int tau = 0; tau < 16; ++tau) acc[tau] = 0.f;
      for (int pp = 0; pp < 64; ++pp) {
        const float2 c = cm[(d * 16 + h) * 64 + pp], b = bb[(d * 64 + pp) * 16 + h2];
        const float zr = c.x * b.x - c.y * b.y, zi = c.x * b.y + c.y * b.x;
#pragma unroll
        for (int tau = 0; tau < 16; ++tau) { const float2 l = lamp[(d * 17 + tau) * 64 + pp]; acc[tau] += zr * l.x - zi * l.y; }
      }
#pragma unroll
      for (int tau = 0; tau < 16; ++tau) ktab[(d * 16 + tau) * 256 + h * 16 + h2] = acc[tau];
    }
    __syncthreads();
    u16* BM_ = (u16*)(p->ws + OFF_BMAT) + (size_t)g * 65536;
    for (int ch = tid; ch < 8192; ch += NTHR) {
      int n = ch >> 5, k8 = (ch & 31) * 8;
      int d = n >> 7, part = (n >> 6) & 1, pp = n & 63, j = k8 >> 4, h0 = k8 & 15;
      float2 l = lamp[(d * 17 + (d == 0 ? 15 - j : j)) * 64 + pp];
      unsigned o[4];
#pragma unroll
      for (int e = 0; e < 8; ++e) {
        float2 b = bb[(d * 64 + pp) * 16 + h0 + e];
        float val = part == 0 ? (l.x * b.x - l.y * b.y) : (l.x * b.y + l.y * b.x);
        if (e & 1) o[e >> 1] |= (unsigned)f2bf(val) << 16; else o[e >> 1] = f2bf(val);
      }
      *(uint4*)(BM_ + n * 256 + k8) = make_uint4(o[0], o[1], o[2], o[3]);
    }
    u16* KC_ = (u16*)(p->ws + OFF_KC) + (size_t)g * 131072;
    for (int ch = tid; ch < 16384; ch += NTHR) {
      int n = ch >> 6, k8 = (ch & 63) * 8;
      int i = n >> 4, h = n & 15;
      unsigned o[4];
#pragma unroll
      for (int e = 0; e < 8; ++e) {
        int k = k8 + e; float val;
        if (k < 256) {
          int j = k >> 4, h2 = k & 15;
          val = 0.f;
          if (j <= i) val += ktab[(0 * 16 + (i - j)) * 256 + h * 16 + h2];
          if (j >= i) val += ktab[(1 * 16 + (j - i)) * 256 + h * 16 + h2];
          if (j == i && h == h2) val += p->in[I_SD][g * 16 + h];
        } else {
          int kk = k - 256, d = kk >> 7, part = (kk >> 6) & 1, pp = kk & 63;
          int ex = d == 0 ? i + 1 : 16 - i;
          float2 c = cm[(d * 16 + h) * 64 + pp], l = lamp[(d * 17 + ex) * 64 + pp];
          val = part == 0 ? (c.x * l.x - c.y * l.y) : -(c.x * l.y + c.y * l.x);
        }
        if (e & 1) o[e >> 1] |= (unsigned)f2bf(val) << 16; else o[e >> 1] = f2bf(val);
      }
      *(uint4*)(KC_ + n * 512 + k8) = make_uint4(o[0], o[1], o[2], o[3]);
    }
    __syncthreads();
  }
  if (G > 128) { if (bid < G - 64) conv_run<0>(p, tid, smem, bid, G - 64); }
  else conv_run<0>(p, tid, smem, bid, G);
  {
    u16* LT = (u16*)(p->ws + OFF_LORAT);
    for (int ch = bid * NTHR + tid; ch < 5120 * 48; ch += G * NTHR) {
      int n = ch / 48, rem = ch % 48, kb = rem >> 3, part = rem & 7, sec = n >> 10;
      bool nz = (sec < 4) ? (kb == sec) : (kb >= 4);
      if (!nz) *(uint4*)(LT + (size_t)n * 384 + kb * 64 + part * 8) = make_uint4(0, 0, 0, 0);
    }
  }
}

DEVI float red8(float x) { x += dppf<0xB1>(x); x += dppf<0x4E>(x); x += dppf<0x141>(x); return x; }
DEVI void phase3_prep(KP p, const int tid, int bid, int G) {
  const int slot = tid >> 7, t = tid & 127;
  const h16* ZRW = (const h16*)(p->ws + OFF_D);
  h16* Rb = (h16*)(p->ws + OFF_A); h16* Kb = Rb + (size_t)NTOK * 1024;
  h16* Vb = (h16*)(p->ws + OFF_B); h16* KKb = Vb + (size_t)NTOK * 1024;
  u16* LA = (u16*)(p->ws + OFF_LA);
  const float* mu = p->in[I_MU];
  for (int r = bid * 4 + slot; r < NTOK; r += G * 4) {
    int ru, rd, rl, rr; float fu, fd, fl, frr;
    if (r < NLAT) { int l = r & 4095, gr = l >> 6, gc = l & 63;
      fu = gr > 0; fd = gr < 63; fl = gc > 0; frr = gc < 63;
      ru = gr > 0 ? r - 64 : r; rd = gr < 63 ? r + 64 : r; rl = gc > 0 ? r - 1 : r; rr = gc < 63 ? r + 1 : r; }
    else { int l = (r - NLAT) & 255; fu = l > 0; fd = l < 255; fl = 0.f; frr = 0.f; ru = l > 0 ? r - 1 : r; rd = l < 255 ? r + 1 : r; rl = r; rr = r; }
    const float inv = 1.f / (fu + fd + fl + frr);
    fu *= inv; fd *= inv; fl *= inv; frr *= inv;
#define ZS8(c, o) do { h16x8 z_ = *(const h16x8*)(ZRW + (size_t)r * ZRWP + (c)); h16x8 u_ = *(const h16x8*)(ZRW + (size_t)ru * ZRWP + (c)); \
      h16x8 d_ = *(const h16x8*)(ZRW + (size_t)rd * ZRWP + (c)); h16x8 l_ = *(const h16x8*)(ZRW + (size_t)rl * ZRWP + (c)); h16x8 r_ = *(const h16x8*)(ZRW + (size_t)rr * ZRWP + (c)); \
      float4 ma_ = *(const float4*)(mu + (c)), mb_ = *(const float4*)(mu + (c) + 4); \
      const float mm_[8] = {ma_.x, ma_.y, ma_.z, ma_.w, mb_.x, mb_.y, mb_.z, mb_.w}; \
      _Pragma("unroll") for (int e = 0; e < 8; ++e) { float z = (float)z_[e]; \
        float m = fu * (float)u_[e] + fd * (float)d_[e] + fl * (float)l_[e] + frr * (float)r_[e]; o[e] = z + (m - z) * mm_[e]; } } while (0)
    float zr[8], zk[8], zv[8];
    ZS8(8 * t, zr); ZS8(1024 + 8 * t, zk); ZS8(2048 + 8 * t, zv);
    h16x8 o;
#pragma unroll
    for (int e = 0; e < 8; ++e) o[e] = (h16)zr[e];
    *(h16x8*)(Rb + (size_t)r * 1024 + 8 * t) = o;
#pragma unroll
    for (int e = 0; e < 8; ++e) o[e] = (h16)zk[e];
    *(h16x8*)(Kb + (size_t)r * 1024 + 8 * t) = o;
#pragma unroll
    for (int e = 0; e < 8; ++e) o[e] = (h16)zv[e];
    *(h16x8*)(Vb + (size_t)r * 1024 + 8 * t) = o;
    {
      float4 ka_ = *(const float4*)(p->in[I_KK] + 8 * t), kb_ = *(const float4*)(p->in[I_KK] + 8 * t + 4);
      const float kw[8] = {ka_.x, ka_.y, ka_.z, ka_.w, kb_.x, kb_.y, kb_.z, kb_.w};
      float kx[8]; float ss = 0.f;
#pragma unroll
      for (int e = 0; e < 8; ++e) { kx[e] = zk[e] * kw[e]; ss += kx[e] * kx[e]; }
      ss = red8(ss);
      const float rs = rsqrtf(ss + 1e-12f);
#pragma unroll
      for (int e = 0; e < 8; ++e) o[e] = (h16)(kx[e] * rs);
      *(h16x8*)(KKb + (size_t)r * 1024 + 8 * t) = o;
    }
    if (t < 48) {
      float zl[8];
      ZS8(3072 + 8 * t, zl);
      const int c = 8 * t;
      unsigned w[4];
#pragma unroll
      for (int e = 0; e < 8; e += 2) {
        float a = zl[e], b = zl[e + 1];
        if (c < 128) { a = tanh_(a); b = tanh_(b); } else if (c >= 256) { a = sigm(a); b = sigm(b); }
        w[e >> 1] = (unsigned)f2bf(a) | ((unsigned)f2bf(b) << 16);
      }
      *(uint4*)(LA + (size_t)r * 384 + c) = make_uint4(w[0], w[1], w[2], w[3]);
    }
#undef ZS8
  }
}

DEVI void phase4_chunkscan(KP p, const int tid, unsigned char* smem, int bid, int G) {
  const int pp = tid & 63, sl = tid >> 6;
  const float* XLOC = (const float*)p->out;
  u16* U2X = (u16*)(p->ws + OFF_C);
  float2* Fs = (float2*)smem;
  for (int combo = bid; combo < 256; combo += G) {
    const int b = combo >> 7, g = (combo >> 1) & 63, d = combo & 1;
    float are = p->in[I_SARE][(d * 64 + g) * 64 + pp], aim = p->in[I_SAIM][(d * 64 + g) * 64 + pp];
    float dt = expf(p->in[I_SLDT][d * 64 + g]);
    float mr, mi; cpow(are, aim, dt, 16.f, mr, mi);
    float xr[34], xi[34];
#pragma unroll
    for (int i = 0; i < 34; ++i) {
      int q = sl * 34 + i;
      int chunk = q < 16 ? 512 + b * 16 + (d ? 15 - q : q) : b * 256 + (d ? 255 - (q - 16) : (q - 16));
      const float* src = XLOC + ((size_t)g * 544 + chunk) * 256 + d * 128 + pp;
      xr[i] = src[0]; xi[i] = src[64];
    }
    float sr = 0.f, si = 0.f;
#pragma unroll
    for (int i = 0; i < 34; ++i) { float nr = mr * sr - mi * si + xr[i], ni = mr * si + mi * sr + xi[i]; sr = nr; si = ni; }
    Fs[sl * 64 + pp] = make_float2(sr, si);
    float m34r = 1.f, m34i = 0.f;
#pragma unroll
    for (int i = 0; i < 34; ++i) { float nr = m34r * mr - m34i * mi, ni = m34r * mi + m34i * mr; m34r = nr; m34i = ni; }
    __syncthreads();
    float cr = 0.f, ci = 0.f;
#pragma unroll
    for (int s2 = 0; s2 < 7; ++s2) {
      if (s2 < sl) { float2 f = Fs[s2 * 64 + pp]; float nr = m34r * cr - m34i * ci + f.x, ni = m34r * ci + m34i * cr + f.y; cr = nr; ci = ni; }
    }
    sr = cr; si = ci;
#pragma unroll
    for (int i = 0; i < 34; ++i) {
      int q = sl * 34 + i;
      if (q >= 16) {
        int chunk = b * 256 + (d ? 255 - (q - 16) : (q - 16));
        u16* dst = U2X + (size_t)g * GS + (size_t)chunk * 512 + 256 + d * 128 + pp;
        dst[0] = f2bf(sr); dst[64] = f2bf(si);
      }
      float nr = mr * sr - mi * si + xr[i], ni = mr * si + mi * sr + xi[i]; sr = nr; si = ni;
    }
    __syncthreads();
  }
}

struct CJ2 { const float* src; long ld; u16* dst; long ldd; };
DEVI CJ2 cjob_bg(KP p, int idx, int ng) {
  CJ2 j;
  if (idx < 512) { const int nt = idx & 15, kt = idx >> 4, wi = ng * 4; const int sc = wi < 128 ? nt * 128 + wi : 2048 + nt * 128 + wi - 128;
    j.src = p->in[I_GLUW] + (long)(kt * 32) * 4096 + sc; j.ld = 4096; j.dst = (u16*)(p->ws + OFF_GLUT) + (long)(nt * 256 + ng * 4) * 1024 + kt * 32; j.ldd = 1024; }
  else if (idx < 768) { const int q = idx - 512, nt = q & 7, kt = q >> 3;
    j.src = p->in[I_RWP] + (long)(kt * 32) * 2048 + nt * 256 + ng * 4; j.ld = 2048; j.dst = (u16*)(p->ws + OFF_RWPT) + (long)(nt * 256 + ng * 4) * 1024 + kt * 32; j.ldd = 1024; }
  else if (idx < 1280) { const int q = idx - 768, nt = q & 7, kt = q >> 3;
    j.src = p->in[I_WO] + (long)(kt * 32) * 2048 + nt * 256 + ng * 4; j.ld = 2048; j.dst = (u16*)(p->ws + OFF_WOT) + (long)(nt * 256 + ng * 4) * 2048 + kt * 32; j.ldd = 2048; }
  else { const int q = idx - 1280, nt = q % W13A_TILES, kt = q / W13A_TILES, wi = ng * 4; const int sc = wi < 128 ? nt * 128 + wi : DFF + nt * 128 + wi - 128;
    j.src = p->in[I_W13] + (long)(kt * 32) * (2 * DFF) + sc; j.ld = 2 * DFF; j.dst = (u16*)(p->ws + OFF_W13A) + (long)(nt * 256 + ng * 4) * 2048 + kt * 32; j.ldd = 2048; }
  return j;
}
DEVI void cj_load(const CJ2& j, int kg, float4 (&v)[8]) {
  const float* s0 = j.src + (long)(kg * 8) * j.ld;
#pragma unroll
  for (int i = 0; i < 8; ++i) v[i] = ldnt4(s0 + (long)i * j.ld);
}
DEVI void cj_store(const CJ2& j, int kg, const float4 (&v)[8]) {
  u16* d0 = j.dst + kg * 8;
  *(uint4*)(d0) = make_uint4(pk2(v[0].x, v[1].x), pk2(v[2].x, v[3].x), pk2(v[4].x, v[5].x), pk2(v[6].x, v[7].x));
  *(uint4*)(d0 + j.ldd) = make_uint4(pk2(v[0].y, v[1].y), pk2(v[2].y, v[3].y), pk2(v[4].y, v[5].y), pk2(v[6].y, v[7].y));
  *(uint4*)(d0 + 2 * j.ldd) = make_uint4(pk2(v[0].z, v[1].z), pk2(v[2].z, v[3].z), pk2(v[4].z, v[5].z), pk2(v[6].z, v[7].z));
  *(uint4*)(d0 + 3 * j.ldd) = make_uint4(pk2(v[0].w, v[1].w), pk2(v[2].w, v[3].w), pk2(v[4].w, v[5].w), pk2(v[6].w, v[7].w));
}

constexpr int TB = 32, STEPF = 336, BUFB = TB * STEPF * 4, YB_OFF = 2 * BUFB, YG = 16 * 68, YBB = (TB / 4) * YG * 4, NBLK = 4352 / TB;
constexpr int VT_OFF = YB_OFF + 2 * YBB, VTB = 16 * TB * 4;
typedef float f2 __attribute__((ext_vector_type(2)));
DEVI int tokrow(int s, int b, int d) { return s < 256 ? NLAT + b * 256 + (d ? 255 - s : s) : b * 4096 + (d ? 4095 - (s - 256) : (s - 256)); }

template <bool LAT>
DEVI void scan_block(const float* bp, const float* vt, float* yp, int ksl, int rowl, int lin, f2& sa, f2& sb) {
  float4 W[3], KA[3], KD[3], KK[3], R[3];
  float4 V4[8];
#pragma unroll
  for (int i = 0; i < 8; ++i) V4[i] = *(const float4*)(vt + rowl * TB + i * 4);
#define LDSTEP(i, t) do { const float* q_ = bp + (t) * STEPF + ksl * 4; W[i] = *(const float4*)(q_); KA[i] = *(const float4*)(q_ + 64); \
    KD[i] = *(const float4*)(q_ + 128); KK[i] = *(const float4*)(q_ + 192); if (LAT) R[i] = *(const float4*)(q_ + 256); } while (0)
  LDSTEP(0, 0); LDSTEP(1, 1);
  float yacc[4];
#pragma unroll
  for (int t = 0; t < TB; ++t) {
    if (t + 2 < TB) LDSTEP((t + 2) % 3, t + 2);
    const int i = t % 3;
    const f2 kk01 = {KK[i].x, KK[i].y}, kk23 = {KK[i].z, KK[i].w};
    f2 pr = sa * kk01; pr = sb * kk23 + pr;
    const float v = V4[t >> 2][t & 3];
    const f2 vv = {v, v};
    const f2 kd01 = {KD[i].x, KD[i].y}, kd23 = {KD[i].z, KD[i].w}, w01 = {W[i].x, W[i].y}, w23 = {W[i].z, W[i].w};
    const f2 qa = sa * w01 + vv * kd01, qb = sb * w23 + vv * kd23;
    const float u = red16(pr.x + pr.y);
    const f2 uu = {u, u};
    const f2 ka01 = {KA[i].x, KA[i].y}, ka23 = {KA[i].z, KA[i].w};
    sa = qa - uu * ka01; sb = qb - uu * ka23;
    if (LAT) {
      const f2 r01 = {R[i].x, R[i].y}, r23 = {R[i].z, R[i].w};
      f2 y = sa * r01; y = sb * r23 + y;
      yacc[t & 3] = y.x + y.y;
      if ((t & 3) == 3) *(float4*)(yp + (t >> 2) * YG + lin * 4 + (lin >> 4) * 4) = make_float4(yacc[0], yacc[1], yacc[2], yacc[3]);
    }
  }
#undef LDSTEP
}

DEVI void phase5_scan(KP p, const int tid, unsigned char* smem, int bid, int G) {
  for (int unit = bid; unit < 256; unit += G) {
    const int chain = unit >> 2, quarter = unit & 3, b = chain >> 5, head = (chain >> 1) & 15, d = chain & 1;
    const h16* Rb = (const h16*)(p->ws + OFF_A); const h16* Kb = Rb + (size_t)NTOK * 1024;
    const h16* Vb = (const h16*)(p->ws + OFF_B); const h16* KKb = Vb + (size_t)NTOK * 1024;
    const h16* EWb = (const h16*)(p->ws + OFF_FX) + (size_t)d * NTOK * 1024;
    const h16* Ab = (const h16*)(p->ws + OFF_FX) + (size_t)(2 + d) * NTOK * 1024;
    h16* Yd = (h16*)(p->ws + OFF_D) + (size_t)d * NLAT * 1024;
    const bool loader = tid >= 256;
    const int lt = tid - 256, lst = (lt >> 3) & 31, cg8 = lt & 7;
    const int lane = tid & 63, rowl = ((tid >> 6) & 3) * 4 + (lane >> 4), ksl = lane & 15, lin = tid & 255;
    f2 sa = {0.f, 0.f}, sb = {0.f, 0.f};
    float ka[8];
    float4 cv[8];
    const bool bgfirst = (unit == bid);
    constexpr int NBG = 1280 + W13A_TILES * 64;
    const int bg_nsl = (NBG + G - 1) / G;
    h16x8 rR, rK, rKK, rEW, rA; h16x2 rV;
#define LOADRAW(jb) do { int tok_ = tokrow((jb) * TB + lst, b, d); size_t base_ = (size_t)tok_ * 1024 + head * 64 + cg8 * 8; \
      rR = *(const h16x8*)(Rb + base_); rK = *(const h16x8*)(Kb + base_); rKK = *(const h16x8*)(KKb + base_); \
      rEW = *(const h16x8*)(EWb + base_); rA = *(const h16x8*)(Ab + base_); \
      rV = *(const h16x2*)(Vb + (size_t)tok_ * 1024 + head * 64 + quarter * 16 + cg8 * 2); } while (0)
#define CONVERT(bufi) do { float* dst_ = (float*)(smem + (bufi) * BUFB) + lst * STEPF; \
      float fw[8], fkka[8], fkd[8], fkk[8], frv[8]; \
      _Pragma("unroll") for (int e = 0; e < 8; ++e) { float a_ = (float)rA[e], kk_ = (float)rKK[e]; \
        fw[e] = __expf(-(float)rEW[e]); fkka[e] = kk_ * a_; fkd[e] = (float)rK[e] * (1.f + (a_ - 1.f) * ka[e]); fkk[e] = kk_; frv[e] = (float)rR[e]; } \
      *(float4*)(dst_ + cg8 * 8) = make_float4(fw[0], fw[1], fw[2], fw[3]); *(float4*)(dst_ + cg8 * 8 + 4) = make_float4(fw[4], fw[5], fw[6], fw[7]); \
      *(float4*)(dst_ + 64 + cg8 * 8) = make_float4(fkka[0], fkka[1], fkka[2], fkka[3]); *(float4*)(dst_ + 64 + cg8 * 8 + 4) = make_float4(fkka[4], fkka[5], fkka[6], fkka[7]); \
      *(float4*)(dst_ + 128 + cg8 * 8) = make_float4(fkd[0], fkd[1], fkd[2], fkd[3]); *(float4*)(dst_ + 128 + cg8 * 8 + 4) = make_float4(fkd[4], fkd[5], fkd[6], fkd[7]); \
      *(float4*)(dst_ + 192 + cg8 * 8) = make_float4(fkk[0], fkk[1], fkk[2], fkk[3]); *(float4*)(dst_ + 192 + cg8 * 8 + 4) = make_float4(fkk[4], fkk[5], fkk[6], fkk[7]); \
      *(float4*)(dst_ + 256 + cg8 * 8) = make_float4(frv[0], frv[1], frv[2], frv[3]); *(float4*)(dst_ + 256 + cg8 * 8 + 4) = make_float4(frv[4], frv[5], frv[6], frv[7]); \
      { float* vt_ = (float*)(smem + VT_OFF + (bufi) * VTB); vt_[(cg8 * 2) * TB + lst] = (float)rV[0]; vt_[(cg8 * 2 + 1) * TB + lst] = (float)rV[1]; } } while (0)
#define FLUSHY(jb) do { if (lt < 128) { const int t4_ = lt >> 4, row_ = lt & 15; \
      const float* yb_ = (const float*)(smem + YB_OFF + ((jb) & 1) * YBB) + t4_ * YG + row_ * 68; \
      float4 acc_ = *(const float4*)(yb_); \
      _Pragma("unroll") for (int l_ = 1; l_ < 16; ++l_) { const float4 q_ = *(const float4*)(yb_ + l_ * 4); acc_.x += q_.x; acc_.y += q_.y; acc_.z += q_.z; acc_.w += q_.w; } \
      const float ys_[4] = {acc_.x, acc_.y, acc_.z, acc_.w}; \
      _Pragma("unroll") for (int e_ = 0; e_ < 4; ++e_) { const int tok_ = tokrow((jb) * TB + t4_ * 4 + e_, b, d); \
        Yd[(size_t)tok_ * 1024 + head * 64 + quarter * 16 + row_] = (h16)ys_[e_]; } } } while (0)
    if (loader) {
#pragma unroll
      for (int e = 0; e < 8; ++e) ka[e] = p->in[I_KA][head * 64 + cg8 * 8 + e];
      LOADRAW(0); CONVERT(0); LOADRAW(1);
    }
    __syncthreads();
    for (int jb = 0; jb < NBLK; ++jb) {
      if (!loader) {
        const float* bp = (const float*)(smem + (jb & 1) * BUFB);
        float* yp = (float*)(smem + YB_OFF + (jb & 1) * YBB);
        const float* vt = (const float*)(smem + VT_OFF + (jb & 1) * VTB);
        if (jb < 8) scan_block<false>(bp, vt, yp, ksl, rowl, lin, sa, sb);
        else scan_block<true>(bp, vt, yp, ksl, rowl, lin, sa, sb);
      } else {
        if (jb + 1 < NBLK) CONVERT((jb + 1) & 1);
        if (jb + 2 < NBLK) LOADRAW(jb + 2);
        if (jb - 1 >= 8) FLUSHY(jb - 1);
        if (bgfirst && jb >= 10 && jb < 10 + 10 * bg_nsl && bid + G * ((jb - 10) / 10) < NBG) {
          const int ph20 = (jb - 10) % 10, sj = (jb - 10) / 10;
          if (ph20 == 0) { const CJ2 cj = cjob_bg(p, bid + G * sj, lt & 63); cj_load(cj, lt >> 6, cv); }
          else if (ph20 == 1) { const CJ2 cj = cjob_bg(p, bid + G * sj, lt & 63); cj_store(cj, lt >> 6, cv); }
        }
      }
      __syncthreads();
    }
    if (loader) FLUSHY(NBLK - 1);
    __syncthreads();
#undef LOADRAW
#undef CONVERT
#undef FLUSHY
  }
}

DEVI void phase6_post(KP p, const int tid, int bid, int G) {
  const int t = tid;
  const h16* Rb = (const h16*)(p->ws + OFF_A); const h16* Kb = Rb + (size_t)NTOK * 1024;
  const h16* Vb = (const h16*)(p->ws + OFF_B);
  const h16* A0b = (const h16*)(p->ws + OFF_FX) + (size_t)2 * NTOK * 1024; const h16* A1b = A0b + (size_t)NTOK * 1024; const h16* Gb = A1b + (size_t)NTOK * 1024;
  const h16* Y0 = (const h16*)(p->ws + OFF_D); const h16* Y1 = Y0 + (size_t)NLAT * 1024;
  u16* YRW = (u16*)(p->ws + OFF_C);
  const float2 kav = *(const float2*)(p->in[I_KA] + 2 * t), rkv = *(const float2*)(p->in[I_RK] + 2 * t);
  const float2 lw = *(const float2*)(p->in[I_LNW] + 2 * t), lb = *(const float2*)(p->in[I_LNB] + 2 * t);
  for (int r = bid; r < NLAT; r += G) {
    size_t o = (size_t)r * 1024 + 2 * t;
    h16x2 y0 = *(const h16x2*)(Y0 + o), y1 = *(const h16x2*)(Y1 + o);
    float ya = (float)y0[0] + (float)y1[0], yb = (float)y0[1] + (float)y1[1];
    float mean = red32(ya + yb) * (1.f / 64.f);
    float da = ya - mean, db = yb - mean;
    float var = red32(da * da + db * db) * (1.f / 64.f);
    float rs = rsqrtf(var + 64e-5f);
    h16x2 r2 = *(const h16x2*)(Rb + o), k2 = *(const h16x2*)(Kb + o), v2 = *(const h16x2*)(Vb + o);
    h16x2 a0 = *(const h16x2*)(A0b + o), a1 = *(const h16x2*)(A1b + o), g2 = *(const h16x2*)(Gb + o);
    float ra = (float)r2[0], rb = (float)r2[1], ka_ = (float)k2[0], kb_ = (float)k2[1];
    float kd0a = ka_ * (1.f + ((float)a0[0] - 1.f) * kav.x), kd0b = kb_ * (1.f + ((float)a0[1] - 1.f) * kav.y);
    float kd1a = ka_ * (1.f + ((float)a1[0] - 1.f) * kav.x), kd1b = kb_ * (1.f + ((float)a1[1] - 1.f) * kav.y);
    float bs = red32(ra * (kd0a + kd1a) * rkv.x + rb * (kd0b + kd1b) * rkv.y);
    float oa = (da * rs * lw.x + lb.x + bs * (float)v2[0]) * (float)g2[0];
    float ob = (db * rs * lw.y + lb.y + bs * (float)v2[1]) * (float)g2[1];
    *(unsigned*)(YRW + o) = (unsigned)f2bf(oa) | ((unsigned)f2bf(ob) << 16);
  }
}

DEVI void phase7_conv(KP p, const int tid, unsigned char* smem, int bid, int G) { conv_run<1>(p, tid, smem, bid, G); }

#define XB_XCNT(j) (64 * (j))
#define XB_XSUB(j) (1024 + 64 * (j))
#define XB_XGEN(j) (2048 + 64 * (j))
#define XB_TOP 3072
#define XB_TOPGEN 3136
DEVI unsigned xb_ld(unsigned* q) { return __hip_atomic_load(q, __ATOMIC_RELAXED, __HIP_MEMORY_SCOPE_AGENT); }
DEVI unsigned xb_add(unsigned* q, unsigned v) { return __hip_atomic_fetch_add(q, v, __ATOMIC_RELAXED, __HIP_MEMORY_SCOPE_AGENT); }
DEVI unsigned xb_xcc_id() { return (unsigned)__builtin_amdgcn_s_getreg((3 << 11) | 20) & 0xFu; }
DEVI void grid_barrier(unsigned* bar, const unsigned x, const unsigned nloc, const unsigned nx, const int tid) {
  asm volatile("s_waitcnt vmcnt(0) lgkmcnt(0)" ::: "memory");
  __syncthreads();
  if (tid == 0) {
    const unsigned old = xb_add(&bar[XB_XSUB(x)], 1u);
    const unsigned gen = old / nloc;
    if (old + 1u == (gen + 1u) * nloc) {
      __builtin_amdgcn_fence(__ATOMIC_RELEASE, "agent");
      asm volatile("s_waitcnt vmcnt(0)" ::: "memory");
      const unsigned og = xb_add(&bar[XB_TOP], 1u);
      const unsigned tg = og / nx;
      if (og + 1u == (tg + 1u) * nx) xb_add(&bar[XB_TOPGEN], 1u);
      else { while (xb_ld(&bar[XB_TOPGEN]) == tg) __builtin_amdgcn_s_sleep(1); }
      __builtin_amdgcn_fence(__ATOMIC_ACQUIRE, "agent");
      xb_add(&bar[XB_XGEN(x)], 1u);
      asm volatile("s_waitcnt vmcnt(0)" ::: "memory");
    } else {
      while (xb_ld(&bar[XB_XGEN(x)]) == gen) __builtin_amdgcn_s_sleep(1);
      __builtin_amdgcn_fence(__ATOMIC_ACQUIRE, "agent");
      asm volatile("s_waitcnt vmcnt(0)" ::: "memory");
    }
  }
  __syncthreads();
}

template <int ph>
DEVI void run_phase(KP p, const int wv, const int tid, const int bid, const int G, unsigned char* smem) {
  {
    switch (ph) {
      case 0: phase0(p, tid, smem, bid, G); break;
      case 1: row_norm_phase(p, tid, 0, bid, G); break;
      case 3: phase3_prep(p, tid, bid, G); break;
      case 4: phase4_chunkscan(p, tid, smem, bid, G); break;
      case 5: phase5_scan(p, tid, smem, bid, G); break;
      case 6: phase6_post(p, tid, bid, G); break;
      case 7: phase7_conv(p, tid, smem, bid, G); break;
      case 9: row_norm_phase(p, tid, 1, bid, G); break;
      case 12: row_norm_phase(p, tid, 2, bid, G); break;
      default: break;
    }
    int nunits = 0, nsub = 1;
    switch (ph) {
      case 2: nunits = 1124; break;
      case 3: nunits = 192; break;
      case 4: nunits = 680; break;
      case 5: nunits = 128; break;
      case 7: nunits = 256; nsub = 3; break;
      case 8: nunits = 256; break;
      case 10: nunits = 1408; break;
      case 11: nunits = 256; break;
      default: break;
    }
    if (nunits > 0) __syncthreads();
    for (int it0 = 0;; ++it0) {
      const int unit = bid + it0 * G;
      if (unit >= nunits) break;
#pragma unroll
     for (int sub = 0; sub < (ph == 7 ? 3 : 1); ++sub) {
      const u16* A = nullptr; const u16* Bt = nullptr; long lda = 0, ldb = 0; int K = 0, brow = 0, bcol = 0, pm = 0, pn = 0, e0 = 0;
      switch (ph) {
        case 2:
          if (unit < 1088) { tile_map(32, 34, unit, pm, pn); brow = pm * 256; } else { tile_map(2, 18, unit - 1088, pm, pn); brow = NLAT + pm * 256; }
          A = (const u16*)(p->ws + OFF_B); lda = 2048; Bt = (const u16*)(p->ws + OFF_A); ldb = 2048; K = 2048; bcol = pn * 256; break;
        case 3:
          e0 = unit / 3; pm = unit % 3; A = (const u16*)(p->ws + OFF_C) + (size_t)e0 * GS; lda = 512; brow = pm * 256;
          Bt = (const u16*)(p->ws + OFF_BMAT) + (size_t)e0 * 65536; ldb = 256; K = 256; bcol = 0; break;
        case 4:
          tile_map(34, 20, unit, pm, pn); { const int kwin = pn < 8 ? 0 : (pn < 16 ? 128 : 256);
          A = (const u16*)(p->ws + OFF_LA) + kwin; lda = 384; brow = pm * 256;
          Bt = (const u16*)(p->ws + OFF_LORAT) + kwin; ldb = 384; K = 128; bcol = pn * 256; } break;
        case 5:
          e0 = unit >> 1; pm = unit & 1; A = (const u16*)(p->ws + OFF_C) + (size_t)e0 * GS; lda = 512; brow = pm * 256;
          Bt = (const u16*)(p->ws + OFF_KC) + (size_t)e0 * 131072; ldb = 512; K = 512; bcol = 0; break;
        case 7:
          tile_map(32, 8, unit, pm, pn); brow = pm * 256; lda = 1024; ldb = 1024; K = 1024;
          if (sub < 2) { A = (const u16*)(p->ws + OFF_D + 33554432); Bt = (const u16*)(p->ws + OFF_GLUT); bcol = (pn * 2 + sub) * 256; }
          else { A = (const u16*)(p->ws + OFF_C); Bt = (const u16*)(p->ws + OFF_RWPT); bcol = pn * 256; }
          break;
        case 8:
          tile_map(32, 8, unit, pm, pn); A = (const u16*)(p->ws + OFF_B); lda = 2048; brow = pm * 256;
          Bt = (const u16*)(p->ws + OFF_WOT); ldb = 2048; K = 2048; bcol = pn * 256; break;
        case 10:
          tile_map(32, 44, unit, pm, pn); A = (const u16*)(p->ws + OFF_A); lda = 2048; brow = pm * 256;
          Bt = (const u16*)(p->ws + (pn < W13A_TILES ? OFF_W13A : OFF_FX)); ldb = 2048; K = 2048; bcol = pn * 256; break;
        default:
          tile_map(32, 8, unit, pm, pn); A = (const u16*)(p->ws + OFF_C); lda = DFF; brow = pm * 256;
          Bt = (const u16*)(p->ws + OFF_W2T); ldb = DFF; K = DFF; bcol = pn * 256; break;
      }
      f32x4 acc[2][2][4][2];
      gemm_core(wv, (u16*)smem, A, lda, Bt, ldb, K, brow, bcol, acc);
      const int te = wv * 64 + lane_id_opaque();
      const int wid = te >> 6, lane = te & 63, wr = wid >> 2, wc = wid & 3, fr = lane & 15, fq = lane >> 4;
#define QWRITE(Tp, ai, bj) _Pragma("unroll") for (int m = 0; m < 4; ++m) _Pragma("unroll") for (int n = 0; n < 2; ++n) _Pragma("unroll") for (int j = 0; j < 4; ++j) \
        (Tp)[(wr * 64 + m * 16 + fq * 4 + j) * 132 + wc * 32 + n * 16 + fr] = acc[ai][bj][m][n][j];
#define EPI_ALL(BODY) _Pragma("unroll") for (int ai = 0; ai < 2; ++ai) _Pragma("unroll") for (int bj = 0; bj < 2; ++bj) { __builtin_amdgcn_sched_barrier(0); \
      _Pragma("unroll") for (int m = 0; m < 4; ++m) _Pragma("unroll") for (int n = 0; n < 2; ++n) _Pragma("unroll") for (int j = 0; j < 4; ++j) { \
        const int row = brow + ai * 128 + wr * 64 + m * 16 + fq * 4 + j; const int col = bcol + bj * 128 + wc * 32 + n * 16 + fr; \
        const float v = acc[ai][bj][m][n][j]; BODY } }
#define EPI_HALF(BODY) _Pragma("unroll") for (int ai = 0; ai < 2; ++ai) { __builtin_amdgcn_sched_barrier(0); \
      _Pragma("unroll") for (int m = 0; m < 4; ++m) _Pragma("unroll") for (int n = 0; n < 2; ++n) _Pragma("unroll") for (int j = 0; j < 4; ++j) { \
        const int row = brow + ai * 128 + wr * 64 + m * 16 + fq * 4 + j; const int cw = wc * 32 + n * 16 + fr; \
        const float v0 = acc[ai][0][m][n][j]; const float v1 = acc[ai][1][m][n][j]; BODY } }
      switch (ph) {
        case 2: {
          if (pn < 4) { u16* U2X = (u16*)(p->ws + OFF_C);
            EPI_ALL({ U2X[(size_t)(col >> 4) * GS + (size_t)(row >> 4) * 512 + (row & 15) * 16 + (col & 15)] = f2bf(v); }) }
          else if (pn < 18) { h16* ZRW = (h16*)(p->ws + OFF_D);
            EPI_ALL({ ZRW[(size_t)row * ZRWP + (col - 1024)] = (h16)v; }) }
          else { u16* GT = (u16*)(p->ws + OFF_E);
            EPI_ALL({ GT[(size_t)row * 4096 + (col - 4608)] = f2bf(sigm(v)); }) }
        } break;
        case 3: { float* XLOC = p->out;
          EPI_ALL({ if (row < 544) XLOC[((size_t)e0 * 544 + row) * 256 + col] = v; }) } break;
        case 4: {
          const int sec = pn >> 2;
          h16* dst = (h16*)(p->ws + OFF_FX) + (size_t)sec * NTOK * 1024;
          if (sec < 2) { const float* w0 = p->in[I_W0] + sec * 1024;
            EPI_ALL({ const int c = col & 1023; dst[(size_t)row * 1024 + c] = (h16)(0.6065306597126334f * sigm(w0[c] + v)); }) }
          else if (sec < 4) { const float* a0 = p->in[I_A0] + (sec - 2) * 1024;
            EPI_ALL({ const int c = col & 1023; dst[(size_t)row * 1024 + c] = (h16)sigm(a0[c] + v); }) }
          else { EPI_ALL({ const int c = col & 1023; dst[(size_t)row * 1024 + c] = (h16)v; }) }
        } break;
        case 5: { u16* YS = (u16*)(p->ws + OFF_D + 33554432);
          EPI_ALL({ YS[(size_t)(row * 16 + (col >> 4)) * 1024 + e0 * 16 + (col & 15)] = f2bf(gelu_tanh(v)); }) } break;
        case 7: {
          const u16* GT = (const u16*)(p->ws + OFF_E); float* M1 = p->out;
          float* T0 = (float*)smem; float* T1 = (float*)smem + 128 * 132;
          const int c4 = te & 31, r0 = te >> 5;
          if (sub < 2) {
#pragma unroll
            for (int ai = 0; ai < 2; ++ai) {
              QWRITE(T0, ai, 0); QWRITE(T1, ai, 1);
              __syncthreads();
              const int cm_ = pn * 256 + sub * 128 + c4 * 4;
              uint2 gg[8];
#pragma unroll
              for (int i = 0; i < 8; ++i) gg[i] = *(const uint2*)(GT + (size_t)(brow + ai * 128 + r0 + i * 16) * 4096 + cm_);
#pragma unroll
              for (int i = 0; i < 8; ++i) {
                const int r = r0 + i * 16;
                const float4 a = *(const float4*)(T0 + r * 132 + c4 * 4), bq = *(const float4*)(T1 + r * 132 + c4 * 4);
                float4 o;
                o.x = a.x * sigm(bq.x) * bf2f((u16)(gg[i].x & 0xffffu)); o.y = a.y * sigm(bq.y) * bf2f((u16)(gg[i].x >> 16));
                o.z = a.z * sigm(bq.z) * bf2f((u16)(gg[i].y & 0xffffu)); o.w = a.w * sigm(bq.w) * bf2f((u16)(gg[i].y >> 16));
                uint2 ob; ob.x = (unsigned)f2bf(o.x) | ((unsigned)f2bf(o.y) << 16); ob.y = (unsigned)f2bf(o.z) | ((unsigned)f2bf(o.w) << 16);
                *(uint2*)((u16*)M1 + (size_t)(brow + ai * 128 + r) * 2048 + cm_) = ob;
              }
              __syncthreads();
            }
          } else { u16* MG = (u16*)(p->ws + OFF_B);
#pragma unroll
            for (int ai = 0; ai < 2; ++ai)
#pragma unroll
              for (int bj = 0; bj < 2; ++bj) {
                QWRITE(T0, ai, bj);
                __syncthreads();
                const int col = bcol + bj * 128 + c4 * 4;
                uint2 gg[8]; float4 mm[8];
#pragma unroll
                for (int i = 0; i < 8; ++i) { const size_t row = (size_t)(brow + ai * 128 + r0 + i * 16);
                  gg[i] = *(const uint2*)(GT + row * 4096 + 2048 + col); const uint2 mb_ = *(const uint2*)((const u16*)M1 + row * 2048 + col);
                  mm[i] = make_float4(bf2f((u16)(mb_.x & 0xffffu)), bf2f((u16)(mb_.x >> 16)), bf2f((u16)(mb_.y & 0xffffu)), bf2f((u16)(mb_.y >> 16))); }
#pragma unroll
                for (int i = 0; i < 8; ++i) {
                  const int r = r0 + i * 16;
                  const float4 a = *(const float4*)(T0 + r * 132 + c4 * 4);
                  const float o0 = mm[i].x + bf2f((u16)(gg[i].x & 0xffffu)) * a.x, o1 = mm[i].y + bf2f((u16)(gg[i].x >> 16)) * a.y;
                  const float o2 = mm[i].z + bf2f((u16)(gg[i].y & 0xffffu)) * a.z, o3 = mm[i].w + bf2f((u16)(gg[i].y >> 16)) * a.w;
                  uint2 o; o.x = (unsigned)f2bf(o0) | ((unsigned)f2bf(o1) << 16); o.y = (unsigned)f2bf(o2) | ((unsigned)f2bf(o3) << 16);
                  *(uint2*)(MG + (size_t)(brow + ai * 128 + r) * 2048 + col) = o;
                }
                __syncthreads();
              }
          }
        } break;
        case 8: { const float* MOD = (const float*)(p->ws + OFF_MOD); const float* ab = p->in[I_ADAB]; const float* x = p->in[I_X];
          float* T0 = (float*)smem; const int c4 = te & 31, r0 = te >> 5;
#pragma unroll
          for (int ai = 0; ai < 2; ++ai)
#pragma unroll
            for (int bj = 0; bj < 2; ++bj) {
              QWRITE(T0, ai, bj);
              __syncthreads();
              const int col = bcol + bj * 128 + c4 * 4;
              const float4 ga = *(const float4*)(MOD + (brow >> 12) * 12288 + 4096 + col), gb = *(const float4*)(ab + 4096 + col);
              float4 xx[8];
#pragma unroll
              for (int i = 0; i < 8; ++i) xx[i] = *(const float4*)(x + (size_t)(brow + ai * 128 + r0 + i * 16) * 2048 + col);
#pragma unroll
              for (int i = 0; i < 8; ++i) {
                const int r = r0 + i * 16;
                const float4 a = *(const float4*)(T0 + r * 132 + c4 * 4);
                float4 o; o.x = xx[i].x + (ga.x + gb.x) * a.x; o.y = xx[i].y + (ga.y + gb.y) * a.y; o.z = xx[i].z + (ga.z + gb.z) * a.z; o.w = xx[i].w + (ga.w + gb.w) * a.w;
                *(float4*)(p->out + (size_t)(brow + ai * 128 + r) * 2048 + col) = o;
              }
              __syncthreads();
            }
        } break;
        case 10: { u16* ACT = (u16*)(p->ws + OFF_C);
          EPI_HALF({ ACT[(size_t)row * DFF + pn * 128 + cw] = f2bf(silu_(v0) * v1); }) } break;
        default: { const float* MOD = (const float*)(p->ws + OFF_MOD); const float* ab = p->in[I_ADAB];
          float* T0 = (float*)smem; const int c4 = te & 31, r0 = te >> 5;
#pragma unroll
          for (int ai = 0; ai < 2; ++ai)
#pragma unroll
            for (int bj = 0; bj < 2; ++bj) {
              QWRITE(T0, ai, bj);
              __syncthreads();
              const int col = bcol + bj * 128 + c4 * 4;
              const float4 ga = *(const float4*)(MOD + (brow >> 12) * 12288 + 10240 + col), gb = *(const float4*)(ab + 10240 + col);
              float4 xx[8];
#pragma unroll
              for (int i = 0; i < 8; ++i) xx[i] = *(const float4*)(p->out + (size_t)(brow + ai * 128 + r0 + i * 16) * 2048 + col);
#pragma unroll
              for (int i = 0; i < 8; ++i) {
                const int r = r0 + i * 16;
                const float4 a = *(const float4*)(T0 + r * 132 + c4 * 4);
                float4 o; o.x = xx[i].x + (ga.x + gb.x) * a.x; o.y = xx[i].y + (ga.y + gb.y) * a.y; o.z = xx[i].z + (ga.z + gb.z) * a.z; o.w = xx[i].w + (ga.w + gb.w) * a.w;
                *(float4*)(p->out + (size_t)(brow + ai * 128 + r) * 2048 + col) = o;
              }
              __syncthreads();
            }
        } break;
      }
     }
    }
    if (ph == 2 && G > 100 && bid >= 100) { __syncthreads(); conv_run<2>(p, wv * 64 + lane_id_opaque(), smem, bid - 100, G - 100); }
  }
}

__global__ void __launch_bounds__(NTHR, 2) mega(Params p_arg) {
  extern __shared__ __attribute__((aligned(16))) unsigned char smem[];
  const int G = gridDim.x;
  const int ph_lo = p_arg.ph_lo, ph_hi = p_arg.ph_hi;
  const int wv = __builtin_amdgcn_readfirstlane((int)threadIdx.x >> 6);
  const unsigned xcc = xb_xcc_id();
  unsigned nloc = 1u, nx = 1u;
  if (ph_hi > 1000) cg::this_grid().sync();
  if (ph_hi - ph_lo > 1) {
    unsigned* bar = (unsigned*)(p_arg.ws + OFF_XB);
    if (threadIdx.x == 0) (void)xb_add(&bar[XB_XCNT(xcc)], 1u);
  }
#define PHASE(k) if (ph_lo <= (k) && (k) < ph_hi) { \
    const int tid = wv * 64 + lane_id_opaque(); \
    int bid = blockIdx.x; asm volatile("" : "+s"(bid)); \
    KP p = (KP)__builtin_amdgcn_kernarg_segment_ptr(); asm volatile("" : "+s"(p)); \
    run_phase<k>(p, wv, tid, bid, G, smem); \
    if ((k) + 1 < ph_hi) { if ((k) == 0) {   \
        unsigned* bar = (unsigned*)(p->ws + OFF_XB); \
        if (wv * 64 + lane_id_opaque() == 0) { for (;;) { unsigned sum = 0u; _Pragma("unroll") for (unsigned j = 0; j < 16; ++j) sum += xb_ld(&bar[XB_XCNT(j)]); if (sum == (unsigned)G) break; __builtin_amdgcn_s_sleep(1); } } \
        __syncthreads(); \
        unsigned mine = 0u, cnt = 0u; \
        _Pragma("unroll") for (unsigned j = 0; j < 16; ++j) { const unsigned c = xb_ld(&bar[XB_XCNT(j)]); cnt += (c > 0u) ? 1u : 0u; mine = (j == xcc) ? c : mine; } \
        nloc = (unsigned)__builtin_amdgcn_readfirstlane((int)(mine > 0u ? mine : 1u)); nx = (unsigned)__builtin_amdgcn_readfirstlane((int)(cnt > 0u ? cnt : 1u)); } \
      grid_barrier((unsigned*)(p->ws + OFF_XB), xcc, nloc, nx, wv * 64 + lane_id_opaque()); } }
  PHASE(0) PHASE(1) PHASE(2) PHASE(3) PHASE(4) PHASE(5) PHASE(6) PHASE(7) PHASE(8) PHASE(9) PHASE(10) PHASE(11) PHASE(12)
}

extern "C" void kernel_launch(void* const* d_in, const int* in_sizes, int n_in, void* d_out, int out_size, void* d_ws, size_t ws_size,
                              hipStream_t stream) {
  constexpr int LDS_BYTES = 159744;
  static int grid = 0;
  if (grid == 0) {
    if (n_in != 34 || ws_size < WS_END) { fprintf(stderr, "kernel_launch: bad args n_in %d ws %zu (need %zu)\n", n_in, ws_size, (size_t)WS_END); grid = -1; return; }
    int dev = 0, cus = 0, per_cu = 0;
    hipGetDevice(&dev);
    hipDeviceGetAttribute(&cus, hipDeviceAttributeMultiprocessorCount, dev);
    if (hipFuncSetAttribute((const void*)mega, hipFuncAttributeMaxDynamicSharedMemorySize, LDS_BYTES) != hipSuccess) { fprintf(stderr, "hipFuncSetAttribute failed\n"); grid = -1; return; }
    hipOccupancyMaxActiveBlocksPerMultiprocessor(&per_cu, (const void*)mega, NTHR, LDS_BYTES);
    (void)hipGetLastError();
    if (per_cu < 1) per_cu = 1;
    grid = cus;
    fprintf(stderr, "kernel_launch: cus %d per_cu %d grid %d ws %zu\n", cus, per_cu, grid, ws_size);
  }
  if (grid < 0) return;
  hipMemsetAsync((char*)d_ws + OFF_XB, 0, 16384, stream);
  Params p{};
  for (int i = 0; i < 34; ++i) p.in[i] = (const float*)d_in[i];
  p.out = (float*)d_out; p.ws = (unsigned char*)d_ws;
#if ONE_LAUNCH
  p.ph_lo = 0; p.ph_hi = 13;
  void* args[] = {&p};
  hipError_t e = hipLaunchCooperativeKernel((const void*)mega, dim3(grid), dim3(NTHR), args, LDS_BYTES, stream);
  if (e != hipSuccess) fprintf(stderr, "cooperative launch failed: %s\n", hipGetErrorString(e));
#else
  for (int ph = 0; ph < 13; ++ph) {
    p.ph_lo = ph; p.ph_hi = ph + 1;
    hipLaunchKernelGGL(mega, dim3(grid), dim3(NTHR), LDS_BYTES, stream, p);
  }
#endif
}
```

```cpp
#include <hip/hip_runtime.h>
#include <hip/hip_cooperative_groups.h>
#include <cstdio>
namespace cg = cooperative_groups;

#ifndef ONE_LAUNCH
#define ONE_LAUNCH 1
#endif

typedef unsigned short u16;
typedef _Float16 h16;
using bf16x8 = __attribute__((ext_vector_type(8))) short;
using f32x4 = __attribute__((ext_vector_type(4))) float;
using h16x2 = __attribute__((ext_vector_type(2))) _Float16;
using h16x8 = __attribute__((ext_vector_type(8))) _Float16;
#define DEVI __device__ __forceinline__

constexpr int NLAT = 8192, NTOK = 8704;
constexpr int ZRWP = 3584;
constexpr int DFF = 5632;
constexpr int GS = 544 * 512;
constexpr int NTHR = 512;

constexpr size_t ARRB = 17825792;
constexpr size_t OFF_MOD = 0;
constexpr size_t OFF_BAR = 147456;
constexpr size_t OFF_GLUT = 147456 + 256;
constexpr size_t OFF_RWPT = OFF_GLUT + 8388608;
constexpr size_t OFF_WOT = OFF_RWPT + 4194304;
constexpr size_t OFF_LORAT = OFF_WOT + 8388608;
constexpr size_t OFF_BMAT = OFF_LORAT + 3932160;
constexpr size_t OFF_KC = OFF_BMAT + 8388608;
constexpr size_t OFF_LA = OFF_KC + 16777216;
constexpr size_t OFF_A = OFF_LA + 6684672;
constexpr size_t OFF_B = OFF_A + 35651584;
constexpr size_t OFF_FX = OFF_B + 35651584;
constexpr size_t OFF_C = OFF_FX + 89128960;
constexpr size_t OFF_D = OFF_C + 35880960;
constexpr size_t OFF_E = OFF_D + 62390272;
constexpr size_t OFF_XB = OFF_E + 67108864;
constexpr size_t OFF_W2T = OFF_XB + 16384;
constexpr size_t OFF_W13A = OFF_W2T + 23068672;
constexpr int W13A_TILES = 19;
constexpr size_t WS_END = OFF_W13A + (size_t)W13A_TILES * 256 * 2048 * 2;

struct Params {
  const float* in[34];
  float* out;
  unsigned char* ws;
  int ph_lo, ph_hi;
};
typedef const __attribute__((address_space(4))) Params* KP;

enum { I_X = 0, I_C, I_CTX, I_CCTX, I_ADAW, I_ADAB, I_N1W, I_WIN, I_MU, I_SARE, I_SAIM, I_SLDT, I_SBRE, I_SBIM, I_SCRE, I_SCIM,
       I_SD, I_GLUW, I_W0, I_W2, I_A0, I_A2, I_G2, I_KK, I_KA, I_RK, I_LNW, I_LNB, I_RWP, I_WO, I_N2W, I_W13, I_FW2, I_NF };

DEVI float4 ldnt4(const float* q) { f32x4 v = __builtin_nontemporal_load((const f32x4*)q); return make_float4(v[0], v[1], v[2], v[3]); }
DEVI int lane_id_opaque() { int r; asm volatile("v_mbcnt_lo_u32_b32 %0, -1, 0\n\tv_mbcnt_hi_u32_b32 %0, -1, %0" : "=v"(r)); return r; }
DEVI u16 f2bf(float f) { __bf16 x = (__bf16)f; return __builtin_bit_cast(unsigned short, x); }
DEVI unsigned pkbf(float a, float b) { __bf16 x = (__bf16)a, y = (__bf16)b; return (unsigned)__builtin_bit_cast(unsigned short, x) | ((unsigned)__builtin_bit_cast(unsigned short, y) << 16); }
DEVI float bf2f(u16 h) { return __uint_as_float(((unsigned)h) << 16); }
DEVI float sigm(float x) { return 1.f / (1.f + __expf(-x)); }
DEVI float tanh_(float x) { float e = __expf(2.f * x); return 1.f - 2.f / (1.f + e); }
DEVI float gelu_tanh(float x) { float u = 0.7978845608028654f * (x + 0.044715f * x * x * x); return 0.5f * x * (1.f + tanh_(u)); }
DEVI float silu_(float x) { return x / (1.f + __expf(-x)); }
template <int CTRL> DEVI float dppf(float x) {
  return __builtin_bit_cast(float, __builtin_amdgcn_update_dpp(0, __builtin_bit_cast(int, x), CTRL, 0xF, 0xF, false));
}
DEVI float red16(float x) { x += dppf<0xB1>(x); x += dppf<0x4E>(x); x += dppf<0x141>(x); x += dppf<0x140>(x); return x; }
DEVI float red32(float x) { x = red16(x); x += __shfl_xor(x, 16); return x; }
DEVI float red64(float x) { x = red16(x); x += __shfl_xor(x, 16); x += __shfl_xor(x, 32); return x; }
DEVI void cpow(float are, float aim, float dt, float tau, float& re, float& im) {
  float mag = expf(tau * are * dt);
  float th = tau * aim * dt;
  float n = rintf(th * 0.15915494309189535f);
  float r = fmaf(-n, 6.28125f, th);
  r = fmaf(-n, 1.9353071795864769e-3f, r);
  re = mag * cosf(r); im = mag * sinf(r);
}

constexpr int BM = 256, BK = 64, HALF = 128, HT = HALF * BK;
DEVI int lds_byte(int r, int c) {
  int st = (r >> 4) * 2 + (c >> 5), rr = r & 15, cc = c & 31, ob = rr * 64 + cc * 2;
  return st * 1024 + (ob ^ (((ob >> 9) & 1) << 5));
}
DEVI void stage_rc(int b, int& R, int& C) {
  int st = b / 1024, sb = b % 1024, swz = sb ^ (((sb >> 9) & 1) << 5);
  R = (st >> 1) * 16 + swz / 64; C = (st & 1) * 32 + (swz % 64) / 2;
}

DEVI void gemm_core(const int wv_in, u16* shm, const u16* A, long lda, const u16* Bt, long ldb, int K, int brow, int bcol, f32x4 (&acc)[2][2][4][2]) {
#define SA(b, h) (shm + ((b) * 2 + (h)) * HT)
#define SB(b, h) (shm + (4 + (b) * 2 + (h)) * HT)
#define STAGE(P, BASE, LD, OFFS, br, kt) do { const char* _ub = (const char*)((BASE) + (long)(br) * (LD) + (long)(kt) * BK); \
    _Pragma("unroll") for (int _i = 0; _i < 2; ++_i) { \
      __builtin_amdgcn_global_load_lds((const unsigned*)(_ub + OFFS[_i]), \
        (__attribute__((address_space(3))) unsigned*)((char*)(P) + wv_s * 1024 + _i * 8192), 16, 0, 0); } } while (0)
#define LDA(dst, b, h) _Pragma("unroll") for (int m = 0; m < 4; ++m) _Pragma("unroll") for (int k = 0; k < 2; ++k) \
    dst[m][k] = *reinterpret_cast<const bf16x8*>((char*)SA(b, h) + lds_byte(wr * 64 + m * 16 + fr, k * 32 + fq * 8))
#define LDB(dst, b, h) _Pragma("unroll") for (int n = 0; n < 2; ++n) _Pragma("unroll") for (int k = 0; k < 2; ++k) \
    dst[n][k] = *reinterpret_cast<const bf16x8*>((char*)SB(b, h) + lds_byte(wc * 32 + n * 16 + fr, k * 32 + fq * 8))
#define MMA(ai, bj, At, Bq) do { __builtin_amdgcn_s_setprio(1); \
    _Pragma("unroll") for (int m = 0; m < 4; ++m) _Pragma("unroll") for (int n = 0; n < 2; ++n) _Pragma("unroll") for (int k = 0; k < 2; ++k) \
      acc[ai][bj][m][n] = __builtin_amdgcn_mfma_f32_16x16x32_bf16(At[m][k], Bq[n][k], acc[ai][bj][m][n], 0, 0, 0); \
    __builtin_amdgcn_s_setprio(0); } while (0)
#define WAIT_V(n) asm volatile("s_waitcnt vmcnt(" #n ")" ::: "memory")
#define WAIT_L(n) asm volatile("s_waitcnt lgkmcnt(" #n ")" ::: "memory")
#define BAR __builtin_amdgcn_s_barrier()
#define SCHED __builtin_amdgcn_sched_barrier(0)
  const int tid = wv_in * 64 + lane_id_opaque();
  const int wv_s = wv_in;
  const int wid = tid >> 6, lane = tid & 63, wr = wid >> 2, wc = wid & 3, fr = lane & 15, fq = lane >> 4;
#pragma unroll
  for (int a = 0; a < 2; ++a)
#pragma unroll
    for (int b = 0; b < 2; ++b)
#pragma unroll
      for (int m = 0; m < 4; ++m)
#pragma unroll
        for (int n = 0; n < 2; ++n) acc[a][b][m][n] = (f32x4){0.f, 0.f, 0.f, 0.f};
  bf16x8 At[4][2], B0[2][2], B1[2][2];
  const int nt = K / BK;
  unsigned offA[2], offB[2];
#pragma unroll
  for (int i = 0; i < 2; ++i) { int r_, c_; stage_rc(tid * 16 + i * 8192, r_, c_); offA[i] = (unsigned)(r_ * (int)lda + c_) * 2u; offB[i] = (unsigned)(r_ * (int)ldb + c_) * 2u; }
  WAIT_V(0);
  STAGE(SB(0, 0), Bt, ldb, offB, bcol, 0); STAGE(SA(0, 0), A, lda, offA, brow, 0);
  STAGE(SB(0, 1), Bt, ldb, offB, bcol + HALF, 0); STAGE(SA(0, 1), A, lda, offA, brow + HALF, 0);
  if (wr == 1) BAR;
  WAIT_V(4); BAR;
  STAGE(SB(1, 0), Bt, ldb, offB, bcol, 1); STAGE(SA(1, 0), A, lda, offA, brow, 1); STAGE(SB(1, 1), Bt, ldb, offB, bcol + HALF, 1);
  WAIT_V(6); BAR;
  for (int t = 0; t < nt - 2; t += 2) {
    LDB(B0, 0, 0); SCHED; LDA(At, 0, 0); STAGE(SA(1, 1), A, lda, offA, brow + HALF, t + 1);
    WAIT_L(8); BAR; WAIT_L(0); MMA(0, 0, At, B0); BAR; SCHED;
    LDB(B1, 0, 1); STAGE(SB(0, 0), Bt, ldb, offB, bcol, t + 2);
    BAR; WAIT_L(0); MMA(0, 1, At, B1); BAR;
    LDA(At, 0, 1); STAGE(SA(0, 0), A, lda, offA, brow, t + 2);
    BAR; WAIT_L(0); MMA(1, 0, At, B0); BAR; SCHED;
    STAGE(SB(0, 1), Bt, ldb, offB, bcol + HALF, t + 2);
    WAIT_V(6); BAR; MMA(1, 1, At, B1); BAR;
    LDB(B0, 1, 0); SCHED; LDA(At, 1, 0); STAGE(SA(0, 1), A, lda, offA, brow + HALF, t + 2);
    WAIT_L(8); BAR; WAIT_L(0); MMA(0, 0, At, B0); BAR; SCHED;
    LDB(B1, 1, 1); STAGE(SB(1, 0), Bt, ldb, offB, bcol, t + 3);
    BAR; WAIT_L(0); MMA(0, 1, At, B1); BAR;
    LDA(At, 1, 1); STAGE(SA(1, 0), A, lda, offA, brow, t + 3);
    BAR; WAIT_L(0); MMA(1, 0, At, B0); BAR; SCHED;
    STAGE(SB(1, 1), Bt, ldb, offB, bcol + HALF, t + 3);
    WAIT_V(6); BAR; MMA(1, 1, At, B1); BAR;
  }
  { LDB(B0, 0, 0); LDA(At, 0, 0); STAGE(SA(1, 1), A, lda, offA, brow + HALF, nt - 1);
    BAR; WAIT_L(0); MMA(0, 0, At, B0); BAR;
    LDB(B1, 0, 1); BAR; WAIT_L(0); MMA(0, 1, At, B1); BAR;
    LDA(At, 0, 1); WAIT_V(4); BAR; WAIT_L(0); MMA(1, 0, At, B0); MMA(1, 1, At, B1); BAR; }
  { LDB(B0, 1, 0); LDA(At, 1, 0); WAIT_V(2); BAR; WAIT_L(0); MMA(0, 0, At, B0); BAR;
    LDB(B1, 1, 1); WAIT_V(0); BAR; WAIT_L(0); MMA(0, 1, At, B1); BAR;
    LDA(At, 1, 1); BAR; WAIT_L(0); MMA(1, 0, At, B0); MMA(1, 1, At, B1); BAR; }
  if (wr == 0) BAR;
}

DEVI void tile_map(int nM, int nN, int idx, int& pm, int& pn) {
  int nwg = nM * nN; int q = nwg / 8, r = nwg % 8, xcd = idx % 8, off = idx / 8;
  int w = (xcd < r ? xcd * (q + 1) : r * (q + 1) + (xcd - r) * q) + off;
  int nig = 8 * nN, gid = w / nig, fm = gid * 8, gsz = min(nM - fm, 8);
  pm = fm + ((w % nig) % gsz); pn = (w % nig) / gsz;
}

struct ConvJob { const float* src; long ld; u16* dst; long ldd; int zero; };
DEVI void conv_load(const int tid, const ConvJob& j, float4 (&v)[4]) {
  const int rr2 = tid >> 4, cc = (tid & 15) * 4;
  const float* s0 = j.src + (long)(2 * rr2) * j.ld + cc;
  v[0] = ldnt4(s0); v[1] = ldnt4(s0 + j.ld);
  v[2] = ldnt4(s0 + 64); v[3] = ldnt4(s0 + j.ld + 64);
}
DEVI unsigned pk2(float a, float b) { return (unsigned)f2bf(a) | ((unsigned)f2bf(b) << 16); }
DEVI void conv_store(const int tid, unsigned char* smem, const ConvJob& j, const float4 (&v)[4]) {
  unsigned* T = (unsigned*)smem;
  const int rr2 = tid >> 4, cc = (tid & 15) * 4;
  const unsigned zm = j.zero ? 0u : 0xffffffffu;
#define pk2(a, b) (pk2(a, b) & zm)
  T[(cc + 0) * 36 + rr2] = pk2(v[0].x, v[1].x); T[(cc + 1) * 36 + rr2] = pk2(v[0].y, v[1].y);
  T[(cc + 2) * 36 + rr2] = pk2(v[0].z, v[1].z); T[(cc + 3) * 36 + rr2] = pk2(v[0].w, v[1].w);
  T[(cc + 64) * 36 + rr2] = pk2(v[2].x, v[3].x); T[(cc + 65) * 36 + rr2] = pk2(v[2].y, v[3].y);
  T[(cc + 66) * 36 + rr2] = pk2(v[2].z, v[3].z); T[(cc + 67) * 36 + rr2] = pk2(v[2].w, v[3].w);
#undef pk2
  __syncthreads();
#pragma unroll
  for (int h = 0; h < 2; ++h) {
    int n = (tid >> 3) + h * 64, kc = (tid & 7) * 4;
    uint4 o = *(const uint4*)(T + n * 36 + kc);
    *(uint4*)(j.dst + (long)n * j.ldd + kc * 2) = o;
  }
  __syncthreads();
}
DEVI ConvJob conv_job0(KP p, int idx) {
  ConvJob j; j.zero = 0;
  if (idx < 2176) { int nt = idx % 68, kt = idx / 68, n0 = nt * 128; j.zero = (n0 >= 4480 && n0 < 4608); int c0 = n0 < 4480 ? n0 : (j.zero ? 0 : n0 - 128);
    j.src = p->in[I_WIN] + (long)(kt * 64) * 8576 + c0; j.ld = 8576; j.dst = (u16*)(p->ws + OFF_A) + (long)n0 * 2048 + kt * 64; j.ldd = 2048; }
  else { int q = idx - 2176; j.ld = 1024; j.ldd = 384;
    if (q < 32) { int sec = q >> 3, nt = q & 7, d = sec & 1;
      j.src = (sec < 2 ? p->in[I_W2] : p->in[I_A2]) + (long)d * 64 * 1024 + nt * 128; j.dst = (u16*)(p->ws + OFF_LORAT) + (long)(sec * 1024 + nt * 128) * 384 + sec * 64; }
    else { int qq = q - 32, kt = qq >> 3, nt = qq & 7;
      j.src = p->in[I_G2] + (long)(kt * 64) * 1024 + nt * 128; j.dst = (u16*)(p->ws + OFF_LORAT) + (long)(4096 + nt * 128) * 384 + 256 + kt * 64; } }
  return j;
}
DEVI ConvJob conv_job7(KP p, int idx) {
  ConvJob j; j.zero = 0;
  { int kt = idx & 31, nt = (idx >> 5) + 2 * W13A_TILES, n0 = nt * 128, t = n0 >> 8, wi = n0 & 255; int c0 = wi < 128 ? t * 128 : DFF + t * 128;
    j.src = p->in[I_W13] + (long)(kt * 64) * (2 * DFF) + c0; j.ld = 2 * DFF; j.dst = (u16*)(p->ws + OFF_FX) + (long)n0 * 2048 + kt * 64; j.ldd = 2048; }
  return j;
}
DEVI ConvJob conv_job2(KP p, int idx) {
  ConvJob j; j.zero = 0;
  { int kt = idx % 88, nt = idx / 88, n0 = nt * 128;
    j.src = p->in[I_FW2] + (long)(kt * 64) * 2048 + n0; j.ld = 2048; j.dst = (u16*)(p->ws + OFF_W2T) + (long)n0 * DFF + kt * 64; j.ldd = DFF; }
  return j;
}
template <int WHICH>
DEVI void conv_run(KP p, const int tid, unsigned char* smem, int bid, int G) {
  const int njobs = WHICH == 0 ? 2224 : (WHICH == 1 ? (88 - 2 * W13A_TILES) * 32 : 1408);
  int idx = bid;
  if (idx >= njobs) return;
#define CJOB(i) (WHICH == 0 ? conv_job0(p, (i)) : (WHICH == 1 ? conv_job7(p, (i)) : conv_job2(p, (i))))
  ConvJob ja = CJOB(idx); float4 va[4]; conv_load(tid, ja, va);
  for (;;) {
    const int i1 = idx + G; const bool h1 = i1 < njobs;
    float4 vb[4];
    const ConvJob jb = CJOB(h1 ? i1 : idx); conv_load(tid, jb, vb);
    conv_store(tid, smem, ja, va);
    if (!h1) break;
    const int i2 = i1 + G; const bool h2 = i2 < njobs;
    ja = CJOB(h2 ? i2 : i1); conv_load(tid, ja, va);
    conv_store(tid, smem, jb, vb);
    if (!h2) break;
    idx = i2;
  }
#undef CJOB
}

DEVI void row_norm_phase(KP p, const int tid, int mode, int bid, int G) {
  const int lane = tid & 63, wave = tid >> 6;
  const float* MOD = (const float*)(p->ws + OFF_MOD);
  const float* adab = p->in[I_ADAB];
  const int nrows = (mode == 0) ? NTOK : NLAT;
  for (int r = bid * 8 + wave; r < nrows; r += G * 8) {
    const float* src; int mrow;
    if (mode == 0) { if (r < NLAT) { src = p->in[I_X] + (size_t)r * 2048; mrow = r >> 12; } else { src = p->in[I_CTX] + (size_t)(r - NLAT) * 2048; mrow = 2; } }
    else { src = p->out + (size_t)r * 2048; mrow = r >> 12; }
    float4 v[8]; float ss = 0.f;
#pragma unroll
    for (int i = 0; i < 8; ++i) { v[i] = ldnt4(src + (i * 64 + lane) * 4); ss += v[i].x * v[i].x + v[i].y * v[i].y + v[i].z * v[i].z + v[i].w * v[i].w; }
    ss = red64(ss);
    const float rs = rsqrtf(ss * (1.f / 2048.f) + 1e-6f);
    const float* nw = p->in[mode == 0 ? I_N1W : (mode == 1 ? I_N2W : I_NF)];
    const int shoff = (mode == 0) ? 0 : 6144, scoff = (mode == 0) ? 2048 : 8192;
    u16* dstb = (u16*)(p->ws + (mode == 0 ? OFF_B : OFF_A)) + (size_t)r * 2048;
#pragma unroll
    for (int i = 0; i < 8; ++i) {
      int c = (i * 64 + lane) * 4;
      float4 w4 = *(const float4*)(nw + c);
      float y0 = v[i].x * rs * w4.x, y1 = v[i].y * rs * w4.y, y2 = v[i].z * rs * w4.z, y3 = v[i].w * rs * w4.w;
      if (mode == 2) { *(float4*)(p->out + (size_t)r * 2048 + c) = make_float4(y0, y1, y2, y3); }
      else {
        float4 sh = *(const float4*)(MOD + mrow * 12288 + shoff + c), shb = *(const float4*)(adab + shoff + c);
        float4 sc = *(const float4*)(MOD + mrow * 12288 + scoff + c), scb = *(const float4*)(adab + scoff + c);
        y0 = y0 * (1.f + sc.x + scb.x) + sh.x + shb.x; y1 = y1 * (1.f + sc.y + scb.y) + sh.y + shb.y;
        y2 = y2 * (1.f + sc.z + scb.z) + sh.z + shb.z; y3 = y3 * (1.f + sc.w + scb.w) + sh.w + shb.w;
        uint2 o; o.x = (unsigned)f2bf(y0) | ((unsigned)f2bf(y1) << 16); o.y = (unsigned)f2bf(y2) | ((unsigned)f2bf(y3) << 16);
        *(uint2*)(dstb + c) = o;
      }
    }
  }
}

DEVI void phase0(KP p, const int tid, unsigned char* smem, int bid, int G) {
  {
    float* sv = (float*)smem;
    float* red = (float*)(smem + 24576);
    for (int i = tid; i < 3 * 2048; i += NTHR) {
      int j = i >> 11, k = i & 2047;
      float cv = (j < 2) ? p->in[I_C][j * 2048 + k] : p->in[I_CCTX][k];
      sv[i] = silu_(cv);
    }
    __syncthreads();
    float* MOD = (float*)(p->ws + OFF_MOD);
    const float* aw = p->in[I_ADAW];
    for (int cb = bid; cb < 256; cb += G) {
      const int cgq = tid % 12, ksl = tid / 12;
      float a0[4] = {0, 0, 0, 0}, a1[4] = {0, 0, 0, 0}, a2[4] = {0, 0, 0, 0};
      if (tid < 504) {
        const float* wp = aw + cb * 48 + cgq * 4;
#pragma unroll 7
        for (int k = ksl; k < 2048; k += 42) {
          float4 wv = ldnt4(wp + (size_t)k * 12288);
          float s0 = sv[k], s1 = sv[2048 + k], s2 = sv[4096 + k];
          a0[0] += s0 * wv.x; a0[1] += s0 * wv.y; a0[2] += s0 * wv.z; a0[3] += s0 * wv.w;
          a1[0] += s1 * wv.x; a1[1] += s1 * wv.y; a1[2] += s1 * wv.z; a1[3] += s1 * wv.w;
          a2[0] += s2 * wv.x; a2[1] += s2 * wv.y; a2[2] += s2 * wv.z; a2[3] += s2 * wv.w;
        }
        float* rp = red + (ksl * 12 + cgq) * 12;
#pragma unroll
        for (int e = 0; e < 4; ++e) { rp[e] = a0[e]; rp[4 + e] = a1[e]; rp[8 + e] = a2[e]; }
      }
      __syncthreads();
      if (tid < 144) {
        const int j = tid / 48, c = tid % 48;
        float sum = 0.f;
        for (int q = 0; q < 42; ++q) sum += red[(q * 12 + (c >> 2)) * 12 + j * 4 + (c & 3)];
        MOD[j * 12288 + cb * 48 + c] = sum;
      }
      __syncthreads();
    }
  }
  for (int g = G - 1 - bid; g < 64 && g >= 0; g += G) {
    float2* lamp = (float2*)smem;
    float2* bb = (float2*)(smem + 17408);
    float2* cm = (float2*)(smem + 17408 + 16384);
    float* ktab = (float*)(smem + 17408 + 32768);
    for (int i = tid; i < 2 * 17 * 64; i += NTHR) {
      int d = i / (17 * 64), tau = (i / 64) % 17, pp = i & 63;
      float are = p->in[I_SARE][(d * 64 + g) * 64 + pp], aim = p->in[I_SAIM][(d * 64 + g) * 64 + pp];
      float dt = expf(p->in[I_SLDT][d * 64 + g]);
      float re, im; cpow(are, aim, dt, (float)tau, re, im);
      lamp[i] = make_float2(re, im);
    }
    for (int i = tid; i < 2048; i += NTHR) {
      int d = i >> 10, pp = (i >> 4) & 63, h = i & 15;
      float are = p->in[I_SARE][(d * 64 + g) * 64 + pp], aim = p->in[I_SAIM][(d * 64 + g) * 64 + pp];
      float dt = expf(p->in[I_SLDT][d * 64 + g]);
      float lr, li; cpow(are, aim, dt, 1.f, lr, li);
      float nr = lr - 1.f, ni = li, den = 1.f / (are * are + aim * aim);
      float qr = (nr * are + ni * aim) * den, qi = (ni * are - nr * aim) * den;
      float br = p->in[I_SBRE][((size_t)(d * 64 + g) * 64 + pp) * 16 + h], bi = p->in[I_SBIM][((size_t)(d * 64 + g) * 64 + pp) * 16 + h];
      bb[i] = make_float2(qr * br - qi * bi, qr * bi + qi * br);
      int h2 = (i >> 6) & 15, p2 = i & 63;
      cm[i] = make_float2(p->in[I_SCRE][((size_t)(d * 64 + g) * 16 + h2) * 64 + p2], p->in[I_SCIM][((size_t)(d * 64 + g) * 16 + h2) * 64 + p2]);
    }
    __syncthreads();
    {
      const int d = tid >> 8, h = (tid >> 4) & 15, h2 = tid & 15;
      float acc[16];
#pragma unroll
      for (int tau = 0; tau < 16; ++tau) acc[tau] = 0.f;
      for (int pp = 0; pp < 64; ++pp) {
        const float2 c = cm[(d * 16 + h) * 64 + pp], b = bb[(d * 64 + pp) * 16 + h2];
        const float zr = c.x * b.x - c.y * b.y, zi = c.x * b.y + c.y * b.x;
#pragma unroll
        for (int tau = 0; tau < 16; ++tau) { const float2 l = lamp[(d * 17 + tau) * 64 + pp]; acc[tau] += zr * l.x - zi * l.y; }
      }
#pragma unroll
      for (int tau = 0; tau < 16; ++tau) ktab[(d * 16 + tau) * 256 + h * 16 + h2] = acc[tau];
    }
    __syncthreads();
    u16* BM_ = (u16*)(p->ws + OFF_BMAT) + (size_t)g * 65536;
    for (int ch = tid; ch < 8192; ch += NTHR) {
      int n = ch >> 5, k8 = (ch & 31) * 8;
      int d = n >> 7, part = (n >> 6) & 1, pp = n & 63, j = k8 >> 4, h0 = k8 & 15;
      float2 l = lamp[(d * 17 + (d == 0 ? 15 - j : j)) * 64 + pp];
      unsigned o[4];
#pragma unroll
      for (int e = 0; e < 8; ++e) {
        float2 b = bb[(d * 64 + pp) * 16 + h0 + e];
        float val = part == 0 ? (l.x * b.x - l.y * b.y) : (l.x * b.y + l.y * b.x);
        if (e & 1) o[e >> 1] |= (unsigned)f2bf(val) << 16; else o[e >> 1] = f2bf(val);
      }
      *(uint4*)(BM_ + n * 256 + k8) = make_uint4(o[0], o[1], o[2], o[3]);
    }
    u16* KC_ = (u16*)(p->ws + OFF_KC) + (size_t)g * 131072;
    for (int ch = tid; ch < 16384; ch += NTHR) {
      int n = ch >> 6, k8 = (ch & 63) * 8;
      int i = n >> 4, h = n & 15;
      unsigned o[4];
#pragma unroll
      for (int e = 0; e < 8; ++e) {
        int k = k8 + e; float val;
        if (k < 256) {
          int j = k >> 4, h2 = k & 15;
          val = 0.f;
          if (j <= i) val += ktab[(0 * 16 + (i - j)) * 256 + h * 16 + h2];
          if (j >= i) val += ktab[(1 * 16 + (j - i)) * 256 + h * 16 + h2];
          if (j == i && h == h2) val += p->in[I_SD][g * 16 + h];
        } else {
          int kk = k - 256, d = kk >> 7, part = (kk >> 6) & 1, pp = kk & 63;
          int ex = d == 0 ? i + 1 : 16 - i;
          float2 c = cm[(d * 16 + h) * 64 + pp], l = lamp[(d * 17 + ex) * 64 + pp];
          val = part == 0 ? (c.x * l.x - c.y * l.y) : -(c.x * l.y + c.y * l.x);
        }
        if (e & 1) o[e >> 1] |= (unsigned)f2bf(val) << 16; else o[e >> 1] = f2bf(val);
      }
      *(uint4*)(KC_ + n * 512 + k8) = make_uint4(o[0], o[1], o[2], o[3]);
    }
    __syncthreads();
  }
  if (G > 128) { if (bid < G - 64) conv_run<0>(p, tid, smem, bid, G - 64); }
  else conv_run<0>(p, tid, smem, bid, G);
  {
    u16* LT = (u16*)(p->ws + OFF_LORAT);
    for (int ch = bid * NTHR + tid; ch < 5120 * 48; ch += G * NTHR) {
      int n = ch / 48, rem = ch % 48, kb = rem >> 3, part = rem & 7, sec = n >> 10;
      bool nz = (sec < 4) ? (kb == sec) : (kb >= 4);
      if (!nz) *(uint4*)(LT + (size_t)n * 384 + kb * 64 + part * 8) = make_uint4(0, 0, 0, 0);
    }
  }
}

DEVI float red8(float x) { x += dppf<0xB1>(x); x += dppf<0x4E>(x); x += dppf<0x141>(x); return x; }
DEVI void phase3_prep(KP p, const int tid, int bid, int G) {
  const int slot = tid >> 7, t = tid & 127;
  const h16* ZRW = (const h16*)(p->ws + OFF_D);
  h16* Rb = (h16*)(p->ws + OFF_A); h16* Kb = Rb + (size_t)NTOK * 1024;
  h16* Vb = (h16*)(p->ws + OFF_B); h16* KKb = Vb + (size_t)NTOK * 1024;
  u16* LA = (u16*)(p->ws + OFF_LA);
  const float* mu = p->in[I_MU];
  for (int r = bid * 4 + slot; r < NTOK; r += G * 4) {
    int ru, rd, rl, rr; float fu, fd, fl, frr;
    if (r < NLAT) { int l = r & 4095, gr = l >> 6, gc = l & 63;
      fu = gr > 0; fd = gr < 63; fl = gc > 0; frr = gc < 63;
      ru = gr > 0 ? r - 64 : r; rd = gr < 63 ? r + 64 : r; rl = gc > 0 ? r - 1 : r; rr = gc < 63 ? r + 1 : r; }
    else { int l = (r - NLAT) & 255; fu = l > 0; fd = l < 255; fl = 0.f; frr = 0.f; ru = l > 0 ? r - 1 : r; rd = l < 255 ? r + 1 : r; rl = r; rr = r; }
    const float inv = 1.f / (fu + fd + fl + frr);
    fu *= inv; fd *= inv; fl *= inv; frr *= inv;
#define ZS8(c, o) do { h16x8 z_ = *(const h16x8*)(ZRW + (size_t)r * ZRWP + (c)); h16x8 u_ = *(const h16x8*)(ZRW + (size_t)ru * ZRWP + (c)); \
      h16x8 d_ = *(const h16x8*)(ZRW + (size_t)rd * ZRWP + (c)); h16x8 l_ = *(const h16x8*)(ZRW + (size_t)rl * ZRWP + (c)); h16x8 r_ = *(const h16x8*)(ZRW + (size_t)rr * ZRWP + (c)); \
      float4 ma_ = *(const float4*)(mu + (c)), mb_ = *(const float4*)(mu + (c) + 4); \
      const float mm_[8] = {ma_.x, ma_.y, ma_.z, ma_.w, mb_.x, mb_.y, mb_.z, mb_.w}; \
      _Pragma("unroll") for (int e = 0; e < 8; ++e) { float z = (float)z_[e]; \
        float m = fu * (float)u_[e] + fd * (float)d_[e] + fl * (float)l_[e] + frr * (float)r_[e]; o[e] = z + (m - z) * mm_[e]; } } while (0)
    float zr[8], zk[8], zv[8];
    ZS8(8 * t, zr); ZS8(1024 + 8 * t, zk); ZS8(2048 + 8 * t, zv);
    h16x8 o;
#pragma unroll
    for (int e = 0; e < 8; ++e) o[e] = (h16)zr[e];
    *(h16x8*)(Rb + (size_t)r * 1024 + 8 * t) = o;
#pragma unroll
    for (int e = 0; e < 8; ++e) o[e] = (h16)zk[e];
    *(h16x8*)(Kb + (size_t)r * 1024 + 8 * t) = o;
#pragma unroll
    for (int e = 0; e < 8; ++e) o[e] = (h16)zv[e];
    *(h16x8*)(Vb + (size_t)r * 1024 + 8 * t) = o;
    {
      float4 ka_ = *(const float4*)(p->in[I_KK] + 8 * t), kb_ = *(const float4*)(p->in[I_KK] + 8 * t + 4);
      const float kw[8] = {ka_.x, ka_.y, ka_.z, ka_.w, kb_.x, kb_.y, kb_.z, kb_.w};
      float kx[8]; float ss = 0.f;
#pragma unroll
      for (int e = 0; e < 8; ++e) { kx[e] = zk[e] * kw[e]; ss += kx[e] * kx[e]; }
      ss = red8(ss);
      const float rs = rsqrtf(ss + 1e-12f);
#pragma unroll
      for (int e = 0; e < 8; ++e) o[e] = (h16)(kx[e] * rs);
      *(h16x8*)(KKb + (size_t)r * 1024 + 8 * t) = o;
    }
    if (t < 48) {
      float zl[8];
      ZS8(3072 + 8 * t, zl);
      const int c = 8 * t;
      unsigned w[4];
#pragma unroll
      for (int e = 0; e < 8; e += 2) {
        float a = zl[e], b = zl[e + 1];
        if (c < 128) { a = tanh_(a); b = tanh_(b); } else if (c >= 256) { a = sigm(a); b = sigm(b); }
        w[e >> 1] = (unsigned)f2bf(a) | ((unsigned)f2bf(b) << 16);
      }
      *(uint4*)(LA + (size_t)r * 384 + c) = make_uint4(w[0], w[1], w[2], w[3]);
    }
#undef ZS8
  }
}

DEVI void phase4_chunkscan(KP p, const int tid, unsigned char* smem, int bid, int G) {
  const int pp = tid & 63, sl = tid >> 6;
  const float* XLOC = (const float*)p->out;
  u16* U2X = (u16*)(p->ws + OFF_C);
  float2* Fs = (float2*)smem;
  for (int combo = bid; combo < 256; combo += G) {
    const int b = combo >> 7, g = (combo >> 1) & 63, d = combo & 1;
    float are = p->in[I_SARE][(d * 64 + g) * 64 + pp], aim = p->in[I_SAIM][(d * 64 + g) * 64 + pp];
    float dt = expf(p->in[I_SLDT][d * 64 + g]);
    float mr, mi; cpow(are, aim, dt, 16.f, mr, mi);
    float xr[34], xi[34];
#pragma unroll
    for (int i = 0; i < 34; ++i) {
      int q = sl * 34 + i;
      int chunk = q < 16 ? 512 + b * 16 + (d ? 15 - q : q) : b * 256 + (d ? 255 - (q - 16) : (q - 16));
      const float* src = XLOC + ((size_t)g * 544 + chunk) * 256 + d * 128 + pp;
      xr[i] = src[0]; xi[i] = src[64];
    }
    float sr = 0.f, si = 0.f;
#pragma unroll
    for (int i = 0; i < 34; ++i) { float nr = mr * sr - mi * si + xr[i], ni = mr * si + mi * sr + xi[i]; sr = nr; si = ni; }
    Fs[sl * 64 + pp] = make_float2(sr, si);
    float m34r = 1.f, m34i = 0.f;
#pragma unroll
    for (int i = 0; i < 34; ++i) { float nr = m34r * mr - m34i * mi, ni = m34r * mi + m34i * mr; m34r = nr; m34i = ni; }
    __syncthreads();
    float cr = 0.f, ci = 0.f;
#pragma unroll
    for (int s2 = 0; s2 < 7; ++s2) {
      if (s2 < sl) { float2 f = Fs[s2 * 64 + pp]; float nr = m34r * cr - m34i * ci + f.x, ni = m34r * ci + m34i * cr + f.y; cr = nr; ci = ni; }
    }
    sr = cr; si = ci;
#pragma unroll
    for (int i = 0; i < 34; ++i) {
      int q = sl * 34 + i;
      if (q >= 16) {
        int chunk = b * 256 + (d ? 255 - (q - 16) : (q - 16));
        u16* dst = U2X + (size_t)g * GS + (size_t)chunk * 512 + 256 + d * 128 + pp;
        dst[0] = f2bf(sr); dst[64] = f2bf(si);
      }
      float nr = mr * sr - mi * si + xr[i], ni = mr * si + mi * sr + xi[i]; sr = nr; si = ni;
    }
    __syncthreads();
  }
}

struct CJ2 { const float* src; long ld; u16* dst; long ldd; };
DEVI CJ2 cjob_bg(KP p, int idx, int ng) {
  CJ2 j;
  if (idx < 512) { const int nt = idx & 15, kt = idx >> 4, wi = ng * 4; const int sc = wi < 128 ? nt * 128 + wi : 2048 + nt * 128 + wi - 128;
    j.src = p->in[I_GLUW] + (long)(kt * 32) * 4096 + sc; j.ld = 4096; j.dst = (u16*)(p->ws + OFF_GLUT) + (long)(nt * 256 + ng * 4) * 1024 + kt * 32; j.ldd = 1024; }
  else if (idx < 768) { const int q = idx - 512, nt = q & 7, kt = q >> 3;
    j.src = p->in[I_RWP] + (long)(kt * 32) * 2048 + nt * 256 + ng * 4; j.ld = 2048; j.dst = (u16*)(p->ws + OFF_RWPT) + (long)(nt * 256 + ng * 4) * 1024 + kt * 32; j.ldd = 1024; }
  else if (idx < 1280) { const int q = idx - 768, nt = q & 7, kt = q >> 3;
    j.src = p->in[I_WO] + (long)(kt * 32) * 2048 + nt * 256 + ng * 4; j.ld = 2048; j.dst = (u16*)(p->ws + OFF_WOT) + (long)(nt * 256 + ng * 4) * 2048 + kt * 32; j.ldd = 2048; }
  else { const int q = idx - 1280, nt = q % W13A_TILES, kt = q / W13A_TILES, wi = ng * 4; const int sc = wi < 128 ? nt * 128 + wi : DFF + nt * 128 + wi - 128;
    j.src = p->in[I_W13] + (long)(kt * 32) * (2 * DFF) + sc; j.ld = 2 * DFF; j.dst = (u16*)(p->ws + OFF_W13A) + (long)(nt * 256 + ng * 4) * 2048 + kt * 32; j.ldd = 2048; }
  return j;
}
DEVI void cj_load(const CJ2& j, int kg, float4 (&v)[8]) {
  const float* s0 = j.src + (long)(kg * 8) * j.ld;
#pragma unroll
  for (int i = 0; i < 8; ++i) v[i] = ldnt4(s0 + (long)i * j.ld);
}
DEVI void cj_store(const CJ2& j, int kg, const float4 (&v)[8]) {
  u16* d0 = j.dst + kg * 8;
  *(uint4*)(d0) = make_uint4(pk2(v[0].x, v[1].x), pk2(v[2].x, v[3].x), pk2(v[4].x, v[5].x), pk2(v[6].x, v[7].x));
  *(uint4*)(d0 + j.ldd) = make_uint4(pk2(v[0].y, v[1].y), pk2(v[2].y, v[3].y), pk2(v[4].y, v[5].y), pk2(v[6].y, v[7].y));
  *(uint4*)(d0 + 2 * j.ldd) = make_uint4(pk2(v[0].z, v[1].z), pk2(v[2].z, v[3].z), pk2(v[4].z, v[5].z), pk2(v[6].z, v[7].z));
  *(uint4*)(d0 + 3 * j.ldd) = make_uint4(pk2(v[0].w, v[1].w), pk2(v[2].w, v[3].w), pk2(v[4].w, v[5].w), pk2(v[6].w, v[7].w));
}

constexpr int TB = 32, STEPF = 336, BUFB = TB * STEPF * 4, YB_OFF = 2 * BUFB, YG = 16 * 68, YBB = (TB / 4) * YG * 4, NBLK = 4352 / TB;
constexpr int VT_OFF = YB_OFF + 2 * YBB, VTB = 16 * TB * 4;
typedef float f2 __attribute__((ext_vector_type(2)));
DEVI int tokrow(int s, int b, int d) { return s < 256 ? NLAT + b * 256 + (d ? 255 - s : s) : b * 4096 + (d ? 4095 - (s - 256) : (s - 256)); }

template <bool LAT>
DEVI void scan_block(const float* bp, const float* vt, float* yp, int ksl, int rowl, int lin, f2& sa, f2& sb) {
  float4 W[3], KA[3], KD[3], KK[3], R[3];
  float4 V4[8];
#pragma unroll
  for (int i = 0; i < 8; ++i) V4[i] = *(const float4*)(vt + rowl * TB + i * 4);
#define LDSTEP(i, t) do { const float* q_ = bp + (t) * STEPF + ksl * 4; W[i] = *(const float4*)(q_); KA[i] = *(const float4*)(q_ + 64); \
    KD[i] = *(const float4*)(q_ + 128); KK[i] = *(const float4*)(q_ + 192); if (LAT) R[i] = *(const float4*)(q_ + 256); } while (0)
  LDSTEP(0, 0); LDSTEP(1, 1);
  float yacc[4];
#pragma unroll
  for (int t = 0; t < TB; ++t) {
    if (t + 2 < TB) LDSTEP((t + 2) % 3, t + 2);
    const int i = t % 3;
    const f2 kk01 = {KK[i].x, KK[i].y}, kk23 = {KK[i].z, KK[i].w};
    f2 pr = sa * kk01; pr = sb * kk23 + pr;
    const float v = V4[t >> 2][t & 3];
    const f2 vv = {v, v};
    const f2 kd01 = {KD[i].x, KD[i].y}, kd23 = {KD[i].z, KD[i].w}, w01 = {W[i].x, W[i].y}, w23 = {W[i].z, W[i].w};
    const f2 qa = sa * w01 + vv * kd01, qb = sb * w23 + vv * kd23;
    const float u = red16(pr.x + pr.y);
    const f2 uu = {u, u};
    const f2 ka01 = {KA[i].x, KA[i].y}, ka23 = {KA[i].z, KA[i].w};
    sa = qa - uu * ka01; sb = qb - uu * ka23;
    if (LAT) {
      const f2 r01 = {R[i].x, R[i].y}, r23 = {R[i].z, R[i].w};
      f2 y = sa * r01; y = sb * r23 + y;
      yacc[t & 3] = y.x + y.y;
      if ((t & 3) == 3) *(float4*)(yp + (t >> 2) * YG + lin * 4 + (lin >> 4) * 4) = make_float4(yacc[0], yacc[1], yacc[2], yacc[3]);
    }
  }
#undef LDSTEP
}

DEVI void phase5_scan(KP p, const int tid, unsigned char* smem, int bid, int G) {
  for (int unit = bid; unit < 256; unit += G) {
    const int chain = unit >> 2, quarter = unit & 3, b = chain >> 5, head = (chain >> 1) & 15, d = chain & 1;
    const h16* Rb = (const h16*)(p->ws + OFF_A); const h16* Kb = Rb + (size_t)NTOK * 1024;
    const h16* Vb = (const h16*)(p->ws + OFF_B); const h16* KKb = Vb + (size_t)NTOK * 1024;
    const h16* EWb = (const h16*)(p->ws + OFF_FX) + (size_t)d * NTOK * 1024;
    const h16* Ab = (const h16*)(p->ws + OFF_FX) + (size_t)(2 + d) * NTOK * 1024;
    h16* Yd = (h16*)(p->ws + OFF_D) + (size_t)d * NLAT * 1024;
    const bool loader = tid >= 256;
    const int lt = tid - 256, lst = (lt >> 3) & 31, cg8 = lt & 7;
    const int lane = tid & 63, rowl = ((tid >> 6) & 3) * 4 + (lane >> 4), ksl = lane & 15, lin = tid & 255;
    f2 sa = {0.f, 0.f}, sb = {0.f, 0.f};
    float ka[8];
    float4 cv[8];
    const bool bgfirst = (unit == bid);
    constexpr int NBG = 1280 + W13A_TILES * 64;
    const int bg_nsl = (NBG + G - 1) / G;
    h16x8 rR, rK, rKK, rEW, rA; h16x2 rV;
#define LOADRAW(jb) do { int tok_ = tokrow((jb) * TB + lst, b, d); size_t base_ = (size_t)tok_ * 1024 + head * 64 + cg8 * 8; \
      rR = *(const h16x8*)(Rb + base_); rK = *(const h16x8*)(Kb + base_); rKK = *(const h16x8*)(KKb + base_); \
      rEW = *(const h16x8*)(EWb + base_); rA = *(const h16x8*)(Ab + base_); \
      rV = *(const h16x2*)(Vb + (size_t)tok_ * 1024 + head * 64 + quarter * 16 + cg8 * 2); } while (0)
#define CONVERT(bufi) do { float* dst_ = (float*)(smem + (bufi) * BUFB) + lst * STEPF; \
      float fw[8], fkka[8], fkd[8], fkk[8], frv[8]; \
      _Pragma("unroll") for (int e = 0; e < 8; ++e) { float a_ = (float)rA[e], kk_ = (float)rKK[e]; \
        fw[e] = __expf(-(float)rEW[e]); fkka[e] = kk_ * a_; fkd[e] = (float)rK[e] * (1.f + (a_ - 1.f) * ka[e]); fkk[e] = kk_; frv[e] = (float)rR[e]; } \
      *(float4*)(dst_ + cg8 * 8) = make_float4(fw[0], fw[1], fw[2], fw[3]); *(float4*)(dst_ + cg8 * 8 + 4) = make_float4(fw[4], fw[5], fw[6], fw[7]); \
      *(float4*)(dst_ + 64 + cg8 * 8) = make_float4(fkka[0], fkka[1], fkka[2], fkka[3]); *(float4*)(dst_ + 64 + cg8 * 8 + 4) = make_float4(fkka[4], fkka[5], fkka[6], fkka[7]); \
      *(float4*)(dst_ + 128 + cg8 * 8) = make_float4(fkd[0], fkd[1], fkd[2], fkd[3]); *(float4*)(dst_ + 128 + cg8 * 8 + 4) = make_float4(fkd[4], fkd[5], fkd[6], fkd[7]); \
      *(float4*)(dst_ + 192 + cg8 * 8) = make_float4(fkk[0], fkk[1], fkk[2], fkk[3]); *(float4*)(dst_ + 192 + cg8 * 8 + 4) = make_float4(fkk[4], fkk[5], fkk[6], fkk[7]); \
      *(float4*)(dst_ + 256 + cg8 * 8) = make_float4(frv[0], frv[1], frv[2], frv[3]); *(float4*)(dst_ + 256 + cg8 * 8 + 4) = make_float4(frv[4], frv[5], frv[6], frv[7]); \
      { float* vt_ = (float*)(smem + VT_OFF + (bufi) * VTB); vt_[(cg8 * 2) * TB + lst] = (float)rV[0]; vt_[(cg8 * 2 + 1) * TB + lst] = (float)rV[1]; } } while (0)
#define FLUSHY(jb) do { if (lt < 128) { const int t4_ = lt >> 4, row_ = lt & 15; \
      const float* yb_ = (const float*)(smem + YB_OFF + ((jb) & 1) * YBB) + t4_ * YG + row_ * 68; \
      float4 acc_ = *(const float4*)(yb_); \
      _Pragma("unroll") for (int l_ = 1; l_ < 16; ++l_) { const float4 q_ = *(const float4*)(yb_ + l_ * 4); acc_.x += q_.x; acc_.y += q_.y; acc_.z += q_.z; acc_.w += q_.w; } \
      const float ys_[4] = {acc_.x, acc_.y, acc_.z, acc_.w}; \
      _Pragma("unroll") for (int e_ = 0; e_ < 4; ++e_) { const int tok_ = tokrow((jb) * TB + t4_ * 4 + e_, b, d); \
        Yd[(size_t)tok_ * 1024 + head * 64 + quarter * 16 + row_] = (h16)ys_[e_]; } } } while (0)
    if (loader) {
#pragma unroll
      for (int e = 0; e < 8; ++e) ka[e] = p->in[I_KA][head * 64 + cg8 * 8 + e];
      LOADRAW(0); CONVERT(0); LOADRAW(1);
    }
    __syncthreads();
    for (int jb = 0; jb < NBLK; ++jb) {
      if (!loader) {
        const float* bp = (const float*)(smem + (jb & 1) * BUFB);
        float* yp = (float*)(smem + YB_OFF + (jb & 1) * YBB);
        const float* vt = (const float*)(smem + VT_OFF + (jb & 1) * VTB);
        if (jb < 8) scan_block<false>(bp, vt, yp, ksl, rowl, lin, sa, sb);
        else scan_block<true>(bp, vt, yp, ksl, rowl, lin, sa, sb);
      } else {
        if (jb + 1 < NBLK) CONVERT((jb + 1) & 1);
        if (jb + 2 < NBLK) LOADRAW(jb + 2);
        if (jb - 1 >= 8) FLUSHY(jb - 1);
        if (bgfirst && jb >= 10 && jb < 10 + 10 * bg_nsl && bid + G * ((jb - 10) / 10) < NBG) {
          const int ph20 = (jb - 10) % 10, sj = (jb - 10) / 10;
          if (ph20 == 0) { const CJ2 cj = cjob_bg(p, bid + G * sj, lt & 63); cj_load(cj, lt >> 6, cv); }
          else if (ph20 == 1) { const CJ2 cj = cjob_bg(p, bid + G * sj, lt & 63); cj_store(cj, lt >> 6, cv); }
        }
      }
      __syncthreads();
    }
    if (loader) FLUSHY(NBLK - 1);
    __syncthreads();
#undef LOADRAW
#undef CONVERT
#undef FLUSHY
  }
}

DEVI void phase6_post(KP p, const int tid, int bid, int G) {
  const int t = tid;
  const h16* Rb = (const h16*)(p->ws + OFF_A); const h16* Kb = Rb + (size_t)NTOK * 1024;
  const h16* Vb = (const h16*)(p->ws + OFF_B);
  const h16* A0b = (const h16*)(p->ws + OFF_FX) + (size_t)2 * NTOK * 1024; const h16* A1b = A0b + (size_t)NTOK * 1024; const h16* Gb = A1b + (size_t)NTOK * 1024;
  const h16* Y0 = (const h16*)(p->ws + OFF_D); const h16* Y1 = Y0 + (size_t)NLAT * 1024;
  u16* YRW = (u16*)(p->ws + OFF_C);
  const float2 kav = *(const float2*)(p->in[I_KA] + 2 * t), rkv = *(const float2*)(p->in[I_RK] + 2 * t);
  const float2 lw = *(const float2*)(p->in[I_LNW] + 2 * t), lb = *(const float2*)(p->in[I_LNB] + 2 * t);
  for (int r = bid; r < NLAT; r += G) {
    size_t o = (size_t)r * 1024 + 2 * t;
    h16x2 y0 = *(const h16x2*)(Y0 + o), y1 = *(const h16x2*)(Y1 + o);
    float ya = (float)y0[0] + (float)y1[0], yb = (float)y0[1] + (float)y1[1];
    float mean = red32(ya + yb) * (1.f / 64.f);
    float da = ya - mean, db = yb - mean;
    float var = red32(da * da + db * db) * (1.f / 64.f);
    float rs = rsqrtf(var + 64e-5f);
    h16x2 r2 = *(const h16x2*)(Rb + o), k2 = *(const h16x2*)(Kb + o), v2 = *(const h16x2*)(Vb + o);
    h16x2 a0 = *(const h16x2*)(A0b + o), a1 = *(const h16x2*)(A1b + o), g2 = *(const h16x2*)(Gb + o);
    float ra = (float)r2[0], rb = (float)r2[1], ka_ = (float)k2[0], kb_ = (float)k2[1];
    float kd0a = ka_ * (1.f + ((float)a0[0] - 1.f) * kav.x), kd0b = kb_ * (1.f + ((float)a0[1] - 1.f) * kav.y);
    float kd1a = ka_ * (1.f + ((float)a1[0] - 1.f) * kav.x), kd1b = kb_ * (1.f + ((float)a1[1] - 1.f) * kav.y);
    float bs = red32(ra * (kd0a + kd1a) * rkv.x + rb * (kd0b + kd1b) * rkv.y);
    float oa = (da * rs * lw.x + lb.x + bs * (float)v2[0]) * (float)g2[0];
    float ob = (db * rs * lw.y + lb.y + bs * (float)v2[1]) * (float)g2[1];
    *(unsigned*)(YRW + o) = (unsigned)f2bf(oa) | ((unsigned)f2bf(ob) << 16);
  }
}

DEVI void phase7_conv(KP p, const int tid, unsigned char* smem, int bid, int G) { conv_run<1>(p, tid, smem, bid, G); }

#define XB_XCNT(j) (64 * (j))
#define XB_XSUB(j) (1024 + 64 * (j))
#define XB_XGEN(j) (2048 + 64 * (j))
#define XB_TOP 3072
#define XB_TOPGEN 3136
DEVI unsigned xb_ld(unsigned* q) { return __hip_atomic_load(q, __ATOMIC_RELAXED, __HIP_MEMORY_SCOPE_AGENT); }
DEVI unsigned xb_add(unsigned* q, unsigned v) { return __hip_atomic_fetch_add(q, v, __ATOMIC_RELAXED, __HIP_MEMORY_SCOPE_AGENT); }
DEVI unsigned xb_xcc_id() { return (unsigned)__builtin_amdgcn_s_getreg((3 << 11) | 20) & 0xFu; }
DEVI void grid_barrier(unsigned* bar, const unsigned x, const unsigned nloc, const unsigned nx, const int tid) {
  asm volatile("s_waitcnt vmcnt(0) lgkmcnt(0)" ::: "memory");
  __syncthreads();
  if (tid == 0) {
    const unsigned old = xb_add(&bar[XB_XSUB(x)], 1u);
    const unsigned gen = old / nloc;
    if (old + 1u == (gen + 1u) * nloc) {
      __builtin_amdgcn_fence(__ATOMIC_RELEASE, "agent");
      asm volatile("s_waitcnt vmcnt(0)" ::: "memory");
      const unsigned og = xb_add(&bar[XB_TOP], 1u);
      const unsigned tg = og / nx;
      if (og + 1u == (tg + 1u) * nx) xb_add(&bar[XB_TOPGEN], 1u);
      else { while (xb_ld(&bar[XB_TOPGEN]) == tg) __builtin_amdgcn_s_sleep(1); }
      __builtin_amdgcn_fence(__ATOMIC_ACQUIRE, "agent");
      xb_add(&bar[XB_XGEN(x)], 1u);
      asm volatile("s_waitcnt vmcnt(0)" ::: "memory");
    } else {
      while (xb_ld(&bar[XB_XGEN(x)]) == gen) __builtin_amdgcn_s_sleep(1);
      __builtin_amdgcn_fence(__ATOMIC_ACQUIRE, "agent");
      asm volatile("s_waitcnt vmcnt(0)" ::: "memory");
    }
  }
  __syncthreads();
}

template <int ph>
DEVI void run_phase(KP p, const int wv, const int tid, const int bid, const int G, unsigned char* smem) {
  {
    switch (ph) {
      case 0: phase0(p, tid, smem, bid, G); break;
      case 1: row_norm_phase(p, tid, 0, bid, G); break;
      case 3: phase3_prep(p, tid, bid, G); break;
      case 4: phase4_chunkscan(p, tid, smem, bid, G); break;
      case 5: phase5_scan(p, tid, smem, bid, G); break;
      case 6: phase6_post(p, tid, bid, G); break;
      case 7: phase7_conv(p, tid, smem, bid, G); break;
      case 9: row_norm_phase(p, tid, 1, bid, G); break;
      case 12: row_norm_phase(p, tid, 2, bid, G); break;
      default: break;
    }
    int nunits = 0, nsub = 1;
    switch (ph) {
      case 2: nunits = 1124; break;
      case 3: nunits = 192; break;
      case 4: nunits = 680; break;
      case 5: nunits = 128; break;
      case 7: nunits = 256; nsub = 3; break;
      case 8: nunits = 256; break;
      case 10: nunits = 1408; break;
      case 11: nunits = 256; break;
      default: break;
    }
    if (nunits > 0) __syncthreads();
    for (int it0 = 0;; ++it0) {
      const int unit = bid + it0 * G;
      if (unit >= nunits) break;
#pragma unroll
     for (int sub = 0; sub < (ph == 7 ? 3 : 1); ++sub) {
      const u16* A = nullptr; const u16* Bt = nullptr; long lda = 0, ldb = 0; int K = 0, brow = 0, bcol = 0, pm = 0, pn = 0, e0 = 0;
      switch (ph) {
        case 2:
          if (unit < 1088) { tile_map(32, 34, unit, pm, pn); brow = pm * 256; } else { tile_map(2, 18, unit - 1088, pm, pn); brow = NLAT + pm * 256; }
          A = (const u16*)(p->ws + OFF_B); lda = 2048; Bt = (const u16*)(p->ws + OFF_A); ldb = 2048; K = 2048; bcol = pn * 256; break;
        case 3:
          e0 = unit / 3; pm = unit % 3; A = (const u16*)(p->ws + OFF_C) + (size_t)e0 * GS; lda = 512; brow = pm * 256;
          Bt = (const u16*)(p->ws + OFF_BMAT) + (size_t)e0 * 65536; ldb = 256; K = 256; bcol = 0; break;
        case 4:
          tile_map(34, 20, unit, pm, pn); { const int kwin = pn < 8 ? 0 : (pn < 16 ? 128 : 256);
          A = (const u16*)(p->ws + OFF_LA) + kwin; lda = 384; brow = pm * 256;
          Bt = (const u16*)(p->ws + OFF_LORAT) + kwin; ldb = 384; K = 128; bcol = pn * 256; } break;
        case 5:
          e0 = unit >> 1; pm = unit & 1; A = (const u16*)(p->ws + OFF_C) + (size_t)e0 * GS; lda = 512; brow = pm * 256;
          Bt = (const u16*)(p->ws + OFF_KC) + (size_t)e0 * 131072; ldb = 512; K = 512; bcol = 0; break;
        case 7:
          tile_map(32, 8, unit, pm, pn); brow = pm * 256; lda = 1024; ldb = 1024; K = 1024;
          if (sub < 2) { A = (const u16*)(p->ws + OFF_D + 33554432); Bt = (const u16*)(p->ws + OFF_GLUT); bcol = (pn * 2 + sub) * 256; }
          else { A = (const u16*)(p->ws + OFF_C); Bt = (const u16*)(p->ws + OFF_RWPT); bcol = pn * 256; }
          break;
        case 8:
          tile_map(32, 8, unit, pm, pn); A = (const u16*)(p->ws + OFF_B); lda = 2048; brow = pm * 256;
          Bt = (const u16*)(p->ws + OFF_WOT); ldb = 2048; K = 2048; bcol = pn * 256; break;
        case 10:
          tile_map(32, 44, unit, pm, pn); A = (const u16*)(p->ws + OFF_A); lda = 2048; brow = pm * 256;
          Bt = (const u16*)(p->ws + (pn < W13A_TILES ? OFF_W13A : OFF_FX)); ldb = 2048; K = 2048; bcol = pn * 256; break;
        default:
          tile_map(32, 8, unit, pm, pn); A = (const u16*)(p->ws + OFF_C); lda = DFF; brow = pm * 256;
          Bt = (const u16*)(p->ws + OFF_W2T); ldb = DFF; K = DFF; bcol = pn * 256; break;
      }
      f32x4 acc[2][2][4][2];
      gemm_core(wv, (u16*)smem, A, lda, Bt, ldb, K, brow, bcol, acc);
      const int te = wv * 64 + lane_id_opaque();
      const int wid = te >> 6, lane = te & 63, wr = wid >> 2, wc = wid & 3, fr = lane & 15, fq = lane >> 4;
#define QWRITE(Tp, ai, bj) _Pragma("unroll") for (int m = 0; m < 4; ++m) _Pragma("unroll") for (int n = 0; n < 2; ++n) _Pragma("unroll") for (int j = 0; j < 4; ++j) \
        (Tp)[(wr * 64 + m * 16 + fq * 4 + j) * 132 + wc * 32 + n * 16 + fr] = acc[ai][bj][m][n][j];
#define EPI_ALL(BODY) _Pragma("unroll") for (int ai = 0; ai < 2; ++ai) _Pragma("unroll") for (int bj = 0; bj < 2; ++bj) { __builtin_amdgcn_sched_barrier(0); \
      _Pragma("unroll") for (int m = 0; m < 4; ++m) _Pragma("unroll") for (int n = 0; n < 2; ++n) _Pragma("unroll") for (int j = 0; j < 4; ++j) { \
        const int row = brow + ai * 128 + wr * 64 + m * 16 + fq * 4 + j; const int col = bcol + bj * 128 + wc * 32 + n * 16 + fr; \
        const float v = acc[ai][bj][m][n][j]; BODY } }
#define EPI_HALF(BODY) _Pragma("unroll") for (int ai = 0; ai < 2; ++ai) { __builtin_amdgcn_sched_barrier(0); \
      _Pragma("unroll") for (int m = 0; m < 4; ++m) _Pragma("unroll") for (int n = 0; n < 2; ++n) _Pragma("unroll") for (int j = 0; j < 4; ++j) { \
        const int row = brow + ai * 128 + wr * 64 + m * 16 + fq * 4 + j; const int cw = wc * 32 + n * 16 + fr; \
        const float v0 = acc[ai][0][m][n][j]; const float v1 = acc[ai][1][m][n][j]; BODY } }
      switch (ph) {
        case 2: {
          if (pn < 4) { u16* U2X = (u16*)(p->ws + OFF_C);
            EPI_ALL({ U2X[(size_t)(col >> 4) * GS + (size_t)(row >> 4) * 512 + (row & 15) * 16 + (col & 15)] = f2bf(v); }) }
          else if (pn < 18) { h16* ZRW = (h16*)(p->ws + OFF_D);
            EPI_ALL({ ZRW[(size_t)row * ZRWP + (col - 1024)] = (h16)v; }) }
          else { u16* GT = (u16*)(p->ws + OFF_E);
            EPI_ALL({ GT[(size_t)row * 4096 + (col - 4608)] = f2bf(sigm(v)); }) }
        } break;
        case 3: { float* XLOC = p->out;
          EPI_ALL({ if (row < 544) XLOC[((size_t)e0 * 544 + row) * 256 + col] = v; }) } break;
        case 4: {
          const int sec = pn >> 2;
          h16* dst = (h16*)(p->ws + OFF_FX) + (size_t)sec * NTOK * 1024;
          if (sec < 2) { const float* w0 = p->in[I_W0] + sec * 1024;
            EPI_ALL({ const int c = col & 1023; dst[(size_t)row * 1024 + c] = (h16)(0.6065306597126334f * sigm(w0[c] + v)); }) }
          else if (sec < 4) { const float* a0 = p->in[I_A0] + (sec - 2) * 1024;
            EPI_ALL({ const int c = col & 1023; dst[(size_t)row * 1024 + c] = (h16)sigm(a0[c] + v); }) }
          else { EPI_ALL({ const int c = col & 1023; dst[(size_t)row * 1024 + c] = (h16)v; }) }
        } break;
        case 5: { u16* YS = (u16*)(p->ws + OFF_D + 33554432);
          EPI_ALL({ YS[(size_t)(row * 16 + (col >> 4)) * 1024 + e0 * 16 + (col & 15)] = f2bf(gelu_tanh(v)); }) } break;
        case 7: {
          const u16* GT = (const u16*)(p->ws + OFF_E); float* M1 = p->out;
          float* T0 = (float*)smem; float* T1 = (float*)smem + 128 * 132;
          const int c4 = te & 31, r0 = te >> 5;
          if (sub < 2) {
#pragma unroll
            for (int ai = 0; ai < 2; ++ai) {
              QWRITE(T0, ai, 0); QWRITE(T1, ai, 1);
              __syncthreads();
              const int cm_ = pn * 256 + sub * 128 + c4 * 4;
              uint2 gg[8];
#pragma unroll
              for (int i = 0; i < 8; ++i) gg[i] = *(const uint2*)(GT + (size_t)(brow + ai * 128 + r0 + i * 16) * 4096 + cm_);
#pragma unroll
              for (int i = 0; i < 8; ++i) {
                const int r = r0 + i * 16;
                const float4 a = *(const float4*)(T0 + r * 132 + c4 * 4), bq = *(const float4*)(T1 + r * 132 + c4 * 4);
                float4 o;
                o.x = a.x * sigm(bq.x) * bf2f((u16)(gg[i].x & 0xffffu)); o.y = a.y * sigm(bq.y) * bf2f((u16)(gg[i].x >> 16));
                o.z = a.z * sigm(bq.z) * bf2f((u16)(gg[i].y & 0xffffu)); o.w = a.w * sigm(bq.w) * bf2f((u16)(gg[i].y >> 16));
                uint2 ob; ob.x = (unsigned)f2bf(o.x) | ((unsigned)f2bf(o.y) << 16); ob.y = (unsigned)f2bf(o.z) | ((unsigned)f2bf(o.w) << 16);
                *(uint2*)((u16*)M1 + (size_t)(brow + ai * 128 + r) * 2048 + cm_) = ob;
              }
              __syncthreads();
            }
          } else { u16* MG = (u16*)(p->ws + OFF_B);
#pragma unroll
            for (int ai = 0; ai < 2; ++ai)
#pragma unroll
              for (int bj = 0; bj < 2; ++bj) {
                QWRITE(T0, ai, bj);
                __syncthreads();
                const int col = bcol + bj * 128 + c4 * 4;
                uint2 gg[8]; float4 mm[8];
#pragma unroll
                for (int i = 0; i < 8; ++i) { const size_t row = (size_t)(brow + ai * 128 + r0 + i * 16);
                  gg[i] = *(const uint2*)(GT + row * 4096 + 2048 + col); const uint2 mb_ = *(const uint2*)((const u16*)M1 + row * 2048 + col);
                  mm[i] = make_float4(bf2f((u16)(mb_.x & 0xffffu)), bf2f((u16)(mb_.x >> 16)), bf2f((u16)(mb_.y & 0xffffu)), bf2f((u16)(mb_.y >> 16))); }
#pragma unroll
                for (int i = 0; i < 8; ++i) {
                  const int r = r0 + i * 16;
                  const float4 a = *(const float4*)(T0 + r * 132 + c4 * 4);
                  const float o0 = mm[i].x + bf2f((u16)(gg[i].x & 0xffffu)) * a.x, o1 = mm[i].y + bf2f((u16)(gg[i].x >> 16)) * a.y;
                  const float o2 = mm[i].z + bf2f((u16)(gg[i].y & 0xffffu)) * a.z, o3 = mm[i].w + bf2f((u16)(gg[i].y >> 16)) * a.w;
                  uint2 o; o.x = (unsigned)f2bf(o0) | ((unsigned)f2bf(o1) << 16); o.y = (unsigned)f2bf(o2) | ((unsigned)f2bf(o3) << 16);
                  *(uint2*)(MG + (size_t)(brow + ai * 128 + r) * 2048 + col) = o;
                }
                __syncthreads();
              }
          }
        } break;
        case 8: { const float* MOD = (const float*)(p->ws + OFF_MOD); const float* ab = p->in[I_ADAB]; const float* x = p->in[I_X];
          float* T0 = (float*)smem; const int c4 = te & 31, r0 = te >> 5;
#pragma unroll
          for (int ai = 0; ai < 2; ++ai)
#pragma unroll
            for (int bj = 0; bj < 2; ++bj) {
              QWRITE(T0, ai, bj);
              __syncthreads();
              const int col = bcol + bj * 128 + c4 * 4;
              const float4 ga = *(const float4*)(MOD + (brow >> 12) * 12288 + 4096 + col), gb = *(const float4*)(ab + 4096 + col);
              float4 xx[8];
#pragma unroll
              for (int i = 0; i < 8; ++i) xx[i] = *(const float4*)(x + (size_t)(brow + ai * 128 + r0 + i * 16) * 2048 + col);
#pragma unroll
              for (int i = 0; i < 8; ++i) {
                const int r = r0 + i * 16;
                const float4 a = *(const float4*)(T0 + r * 132 + c4 * 4);
                float4 o; o.x = xx[i].x + (ga.x + gb.x) * a.x; o.y = xx[i].y + (ga.y + gb.y) * a.y; o.z = xx[i].z + (ga.z + gb.z) * a.z; o.w = xx[i].w + (ga.w + gb.w) * a.w;
                *(float4*)(p->out + (size_t)(brow + ai * 128 + r) * 2048 + col) = o;
              }
              __syncthreads();
            }
        } break;
        case 10: { u16* ACT = (u16*)(p->ws + OFF_C);
          EPI_HALF({ ACT[(size_t)row * DFF + pn * 128 + cw] = f2bf(silu_(v0) * v1); }) } break;
        default: { const float* MOD = (const float*)(p->ws + OFF_MOD); const float* ab = p->in[I_ADAB];
          float* T0 = (float*)smem; const int c4 = te & 31, r0 = te >> 5;
#pragma unroll
          for (int ai = 0; ai < 2; ++ai)
#pragma unroll
            for (int bj = 0; bj < 2; ++bj) {
              QWRITE(T0, ai, bj);
              __syncthreads();
              const int col = bcol + bj * 128 + c4 * 4;
              const float4 ga = *(const float4*)(MOD + (brow >> 12) * 12288 + 10240 + col), gb = *(const float4*)(ab + 10240 + col);
              float4 xx[8];
#pragma unroll
              for (int i = 0; i < 8; ++i) xx[i] = *(const float4*)(p->out + (size_t)(brow + ai * 128 + r0 + i * 16) * 2048 + col);
#pragma unroll
              for (int i = 0; i < 8; ++i) {
                const int r = r0 + i * 16;
                const float4 a = *(const float4*)(T0 + r * 132 + c4 * 4);
                float4 o; o.x = xx[i].x + (ga.x + gb.x) * a.x; o.y = xx[i].y + (ga.y + gb.y) * a.y; o.z = xx[i].z + (ga.z + gb.z) * a.z; o.w = xx[i].w + (ga.w + gb.w) * a.w;
                *(float4*)(p->out + (size_t)(brow + ai * 128 + r) * 2048 + col) = o;
              }
              __syncthreads();
            }
        } break;
      }
     }
    }
    if (ph == 2 && G > 100 && bid >= 100) { __syncthreads(); conv_run<2>(p, wv * 64 + lane_id_opaque(), smem, bid - 100, G - 100); }
  }
}

__global__ void __launch_bounds__(NTHR, 2) mega(Params p_arg) {
  extern __shared__ __attribute__((aligned(16))) unsigned char smem[];
  const int G = gridDim.x;
  const int ph_lo = p_arg.ph_lo, ph_hi = p_arg.ph_hi;
  const int wv = __builtin_amdgcn_readfirstlane((int)threadIdx.x >> 6);
  const unsigned xcc = xb_xcc_id();
  unsigned nloc = 1u, nx = 1u;
  if (ph_hi > 1000) cg::this_grid().sync();
  if (ph_hi - ph_lo > 1) {
    unsigned* bar = (unsigned*)(p_arg.ws + OFF_XB);
    if (threadIdx.x == 0) (void)xb_add(&bar[XB_XCNT(xcc)], 1u);
  }
#define PHASE(k) if (ph_lo <= (k) && (k) < ph_hi) { \
    const int tid = wv * 64 + lane_id_opaque(); \
    int bid = blockIdx.x; asm volatile("" : "+s"(bid)); \
    KP p = (KP)__builtin_amdgcn_kernarg_segment_ptr(); asm volatile("" : "+s"(p)); \
    run_phase<k>(p, wv, tid, bid, G, smem); \
    if ((k) + 1 < ph_hi) { if ((k) == 0) {   \
        unsigned* bar = (unsigned*)(p->ws + OFF_XB); \
        if (wv * 64 + lane_id_opaque() == 0) { for (;;) { unsigned sum = 0u; _Pragma("unroll") for (unsigned j = 0; j < 16; ++j) sum += xb_ld(&bar[XB_XCNT(j)]); if (sum == (unsigned)G) break; __builtin_amdgcn_s_sleep(1); } } \
        __syncthreads(); \
        unsigned mine = 0u, cnt = 0u; \
        _Pragma("unroll") for (unsigned j = 0; j < 16; ++j) { const unsigned c = xb_ld(&bar[XB_XCNT(j)]); cnt += (c > 0u) ? 1u : 0u; mine = (j == xcc) ? c : mine; } \
        nloc = (unsigned)__builtin_amdgcn_readfirstlane((int)(mine > 0u ? mine : 1u)); nx = (unsigned)__builtin_amdgcn_readfirstlane((int)(cnt > 0u ? cnt : 1u)); } \
      grid_barrier((unsigned*)(p->ws + OFF_XB), xcc, nloc, nx, wv * 64 + lane_id_opaque()); } }
  PHASE(0) PHASE(1) PHASE(2) PHASE(3) PHASE(4) PHASE(5) PHASE(6) PHASE(7) PHASE(8) PHASE(9) PHASE(10) PHASE(11) PHASE(12)
}

extern "C" void kernel_launch(void* const* d_in, const int* in_sizes, int n_in, void* d_out, int out_size, void* d_ws, size_t ws_size,
                              hipStream_t stream) {
  constexpr int LDS_BYTES = 159744;
  static int grid = 0;
  if (grid == 0) {
    if (n_in != 34 || ws_size < WS_END) { fprintf(stderr, "kernel_launch: bad args n_in %d ws %zu (need %zu)\n", n_in, ws_size, (size_t)WS_END); grid = -1; return; }
    int dev = 0, cus = 0, per_cu = 0;
    hipGetDevice(&dev);
    hipDeviceGetAttribute(&cus, hipDeviceAttributeMultiprocessorCount, dev);
    if (hipFuncSetAttribute((const void*)mega, hipFuncAttributeMaxDynamicSharedMemorySize, LDS_BYTES) != hipSuccess) { fprintf(stderr, "hipFuncSetAttribute failed\n"); grid = -1; return; }
    hipOccupancyMaxActiveBlocksPerMultiprocessor(&per_cu, (const void*)mega, NTHR, LDS_BYTES);
    (void)hipGetLastError();
    if (per_cu < 1) per_cu = 1;
    grid = cus;
    fprintf(stderr, "kernel_launch: cus %d per_cu %d grid %d ws %zu\n", cus, per_cu, grid, ws_size);
  }
  if (grid < 0) return;
  hipMemsetAsync((char*)d_ws + OFF_XB, 0, 16384, stream);
  Params p{};
  for (int i = 0; i < 34; ++i) p.in[i] = (const float*)d_in[i];
  p.out = (float*)d_out; p.ws = (unsigned char*)d_ws;
#if ONE_LAUNCH
  p.ph_lo = 0; p.ph_hi = 13;
  void* args[] = {&p};
  hipError_t e = hipLaunchCooperativeKernel((const void*)mega, dim3(grid), dim3(NTHR), args, LDS_BYTES, stream);
  if (e != hipSuccess) fprintf(stderr, "cooperative launch failed: %s\n", hipGetErrorString(e));
#else
  for (int ph = 0; ph < 13; ++ph) {
    p.ph_lo = ph; p.ph_hi = ph + 1;
    hipLaunchKernelGGL(mega, dim3(grid), dim3(NTHR), LDS_BYTES, stream, p);
  }
#endif
}
```

```cpp
#include <hip/hip_runtime.h>
#include <hip/hip_cooperative_groups.h>
#include <cstdio>
namespace cg = cooperative_groups;

#ifndef ONE_LAUNCH
#define ONE_LAUNCH 1
#endif

typedef unsigned short u16;
typedef _Float16 h16;
using bf16x8 = __attribute__((ext_vector_type(8))) short;
using f32x4 = __attribute__((ext_vector_type(4))) float;
using h16x2 = __attribute__((ext_vector_type(2))) _Float16;
using h16x8 = __attribute__((ext_vector_type(8))) _Float16;
#define DEVI __device__ __forceinline__

constexpr int NLAT = 8192, NTOK = 8704;
constexpr int ZRWP = 3584;
constexpr int DFF = 5632;
constexpr int GS = 544 * 512;
constexpr int NTHR = 512;

constexpr size_t ARRB = 17825792;
constexpr size_t OFF_MOD = 0;
constexpr size_t OFF_BAR = 147456;
constexpr size_t OFF_GLUT = 147456 + 256;
constexpr size_t OFF_RWPT = OFF_GLUT + 8388608;
constexpr size_t OFF_WOT = OFF_RWPT + 4194304;
constexpr size_t OFF_LORAT = OFF_WOT + 8388608;
constexpr size_t OFF_BMAT = OFF_LORAT + 3932160;
constexpr size_t OFF_KC = OFF_BMAT + 8388608;
constexpr size_t OFF_LA = OFF_KC + 16777216;
constexpr size_t OFF_A = OFF_LA + 6684672;
constexpr size_t OFF_B = OFF_A + 35651584;
constexpr size_t OFF_FX = OFF_B + 35651584;
constexpr size_t OFF_C = OFF_FX + 89128960;
constexpr size_t OFF_D = OFF_C + 35880960;
constexpr size_t OFF_E = OFF_D + 62390272;
constexpr size_t OFF_XB = OFF_E + 67108864;
constexpr size_t OFF_W2T = OFF_XB + 16384;
constexpr size_t OFF_W13A = OFF_W2T + 23068672;
constexpr int W13A_TILES = 19;
constexpr size_t WS_END = OFF_W13A + (size_t)W13A_TILES * 256 * 2048 * 2;

struct Params {
  const float* in[34];
  float* out;
  unsigned char* ws;
  int ph_lo, ph_hi;
};
typedef const __attribute__((address_space(4))) Params* KP;

enum { I_X = 0, I_C, I_CTX, I_CCTX, I_ADAW, I_ADAB, I_N1W, I_WIN, I_MU, I_SARE, I_SAIM, I_SLDT, I_SBRE, I_SBIM, I_SCRE, I_SCIM,
       I_SD, I_GLUW, I_W0, I_W2, I_A0, I_A2, I_G2, I_KK, I_KA, I_RK, I_LNW, I_LNB, I_RWP, I_WO, I_N2W, I_W13, I_FW2, I_NF };

DEVI float4 ldnt4(const float* q) { f32x4 v = __builtin_nontemporal_load((const f32x4*)q); return make_float4(v[0], v[1], v[2], v[3]); }
DEVI int lane_id_opaque() { int r; asm volatile("v_mbcnt_lo_u32_b32 %0, -1, 0\n\tv_mbcnt_hi_u32_b32 %0, -1, %0" : "=v"(r)); return r; }
DEVI u16 f2bf(float f) { __bf16 x = (__bf16)f; return __builtin_bit_cast(unsigned short, x); }
DEVI unsigned pkbf(float a, float b) { __bf16 x = (__bf16)a, y = (__bf16)b; return (unsigned)__builtin_bit_cast(unsigned short, x) | ((unsigned)__builtin_bit_cast(unsigned short, y) << 16); }
DEVI float bf2f(u16 h) { return __uint_as_float(((unsigned)h) << 16); }
DEVI float sigm(float x) { return __builtin_amdgcn_rcpf(1.f + __expf(-x)); }
DEVI float tanh_(float x) { float e = __expf(2.f * x); return 1.f - 2.f * __builtin_amdgcn_rcpf(1.f + e); }
DEVI float gelu_tanh(float x) { float u = 0.7978845608028654f * (x + 0.044715f * x * x * x); return 0.5f * x * (1.f + tanh_(u)); }
DEVI float silu_(float x) { return x * __builtin_amdgcn_rcpf(1.f + __expf(-x)); }
template <int CTRL> DEVI float dppf(float x) {
  return __builtin_bit_cast(float, __builtin_amdgcn_update_dpp(0, __builtin_bit_cast(int, x), CTRL, 0xF, 0xF, false));
}
DEVI float red16(float x) { x += dppf<0xB1>(x); x += dppf<0x4E>(x); x += dppf<0x141>(x); x += dppf<0x140>(x); return x; }
DEVI float red32(float x) { x = red16(x); x += __shfl_xor(x, 16); return x; }
DEVI float red64(float x) { x = red16(x); x += __shfl_xor(x, 16); x += __shfl_xor(x, 32); return x; }
DEVI void cpow(float are, float aim, float dt, float tau, float& re, float& im) {
  float mag = expf(tau * are * dt);
  float th = tau * aim * dt;
  float n = rintf(th * 0.15915494309189535f);
  float r = fmaf(-n, 6.28125f, th);
  r = fmaf(-n, 1.9353071795864769e-3f, r);
  re = mag * cosf(r); im = mag * sinf(r);
}

constexpr int BM = 256, BK = 64, HALF = 128, HT = HALF * BK;
DEVI int lds_byte(int r, int c) {
  int st = (r >> 4) * 2 + (c >> 5), rr = r & 15, cc = c & 31, ob = rr * 64 + cc * 2;
  return st * 1024 + (ob ^ (((ob >> 9) & 1) << 5));
}
DEVI void stage_rc(int b, int& R, int& C) {
  int st = b / 1024, sb = b % 1024, swz = sb ^ (((sb >> 9) & 1) << 5);
  R = (st >> 1) * 16 + swz / 64; C = (st & 1) * 32 + (swz % 64) / 2;
}

DEVI void gemm_core(const int wv_in, u16* shm, const u16* A, long lda, const u16* Bt, long ldb, int K, int brow, int bcol, f32x4 (&acc)[2][2][4][2]) {
#define SA(b, h) (shm + ((b) * 2 + (h)) * HT)
#define SB(b, h) (shm + (4 + (b) * 2 + (h)) * HT)
#define STAGE(P, BASE, LD, OFFS, br, kt) do { const char* _ub = (const char*)((BASE) + (long)(br) * (LD) + (long)(kt) * BK); \
    _Pragma("unroll") for (int _i = 0; _i < 2; ++_i) { \
      __builtin_amdgcn_global_load_lds((const unsigned*)(_ub + OFFS[_i]), \
        (__attribute__((address_space(3))) unsigned*)((char*)(P) + wv_s * 1024 + _i * 8192), 16, 0, 0); } } while (0)
#define LDA(dst, b, h) _Pragma("unroll") for (int m = 0; m < 4; ++m) _Pragma("unroll") for (int k = 0; k < 2; ++k) \
    dst[m][k] = *reinterpret_cast<const bf16x8*>((char*)SA(b, h) + lds_byte(wr * 64 + m * 16 + fr, k * 32 + fq * 8))
#define LDB(dst, b, h) _Pragma("unroll") for (int n = 0; n < 2; ++n) _Pragma("unroll") for (int k = 0; k < 2; ++k) \
    dst[n][k] = *reinterpret_cast<const bf16x8*>((char*)SB(b, h) + lds_byte(wc * 32 + n * 16 + fr, k * 32 + fq * 8))
#define MMA(ai, bj, At, Bq) do { __builtin_amdgcn_s_setprio(1); \
    _Pragma("unroll") for (int m = 0; m < 4; ++m) _Pragma("unroll") for (int n = 0; n < 2; ++n) _Pragma("unroll") for (int k = 0; k < 2; ++k) \
      acc[ai][bj][m][n] = __builtin_amdgcn_mfma_f32_16x16x32_bf16(At[m][k], Bq[n][k], acc[ai][bj][m][n], 0, 0, 0); \
    __builtin_amdgcn_s_setprio(0); } while (0)
#define WAIT_V(n) asm volatile("s_waitcnt vmcnt(" #n ")" ::: "memory")
#define WAIT_L(n) asm volatile("s_waitcnt lgkmcnt(" #n ")" ::: "memory")
#define BAR __builtin_amdgcn_s_barrier()
#define SCHED __builtin_amdgcn_sched_barrier(0)
  const int tid = wv_in * 64 + lane_id_opaque();
  const int wv_s = wv_in;
  const int wid = tid >> 6, lane = tid & 63, wr = wid >> 2, wc = wid & 3, fr = lane & 15, fq = lane >> 4;
#pragma unroll
  for (int a = 0; a < 2; ++a)
#pragma unroll
    for (int b = 0; b < 2; ++b)
#pragma unroll
      for (int m = 0; m < 4; ++m)
#pragma unroll
        for (int n = 0; n < 2; ++n) acc[a][b][m][n] = (f32x4){0.f, 0.f, 0.f, 0.f};
  bf16x8 At[4][2], B0[2][2], B1[2][2];
  const int nt = K / BK;
  unsigned offA[2], offB[2];
#pragma unroll
  for (int i = 0; i < 2; ++i) { int r_, c_; stage_rc(tid * 16 + i * 8192, r_, c_); offA[i] = (unsigned)(r_ * (int)lda + c_) * 2u; offB[i] = (unsigned)(r_ * (int)ldb + c_) * 2u; }
  WAIT_V(0);
  STAGE(SB(0, 0), Bt, ldb, offB, bcol, 0); STAGE(SA(0, 0), A, lda, offA, brow, 0);
  STAGE(SB(0, 1), Bt, ldb, offB, bcol + HALF, 0); STAGE(SA(0, 1), A, lda, offA, brow + HALF, 0);
  if (wr == 1) BAR;
  WAIT_V(4); BAR;
  STAGE(SB(1, 0), Bt, ldb, offB, bcol, 1); STAGE(SA(1, 0), A, lda, offA, brow, 1); STAGE(SB(1, 1), Bt, ldb, offB, bcol + HALF, 1);
  WAIT_V(6); BAR;
  for (int t = 0; t < nt - 2; t += 2) {
    LDB(B0, 0, 0); SCHED; LDA(At, 0, 0); STAGE(SA(1, 1), A, lda, offA, brow + HALF, t + 1);
    WAIT_L(8); BAR; WAIT_L(0); MMA(0, 0, At, B0); BAR; SCHED;
    LDB(B1, 0, 1); STAGE(SB(0, 0), Bt, ldb, offB, bcol, t + 2);
    BAR; WAIT_L(0); MMA(0, 1, At, B1); BAR;
    LDA(At, 0, 1); STAGE(SA(0, 0), A, lda, offA, brow, t + 2);
    BAR; WAIT_L(0); MMA(1, 0, At, B0); BAR; SCHED;
    STAGE(SB(0, 1), Bt, ldb, offB, bcol + HALF, t + 2);
    WAIT_V(6); BAR; MMA(1, 1, At, B1); BAR;
    LDB(B0, 1, 0); SCHED; LDA(At, 1, 0); STAGE(SA(0, 1), A, lda, offA, brow + HALF, t + 2);
    WAIT_L(8); BAR; WAIT_L(0); MMA(0, 0, At, B0); BAR; SCHED;
    LDB(B1, 1, 1); STAGE(SB(1, 0), Bt, ldb, offB, bcol, t + 3);
    BAR; WAIT_L(0); MMA(0, 1, At, B1); BAR;
    LDA(At, 1, 1); STAGE(SA(1, 0), A, lda, offA, brow, t + 3);
    BAR; WAIT_L(0); MMA(1, 0, At, B0); BAR; SCHED;
    STAGE(SB(1, 1), Bt, ldb, offB, bcol + HALF, t + 3);
    WAIT_V(6); BAR; MMA(1, 1, At, B1); BAR;
  }
  { LDB(B0, 0, 0); LDA(At, 0, 0); STAGE(SA(1, 1), A, lda, offA, brow + HALF, nt - 1);
    BAR; WAIT_L(0); MMA(0, 0, At, B0); BAR;
    LDB(B1, 0, 1); BAR; WAIT_L(0); MMA(0, 1, At, B1); BAR;
    LDA(At, 0, 1); WAIT_V(4); BAR; WAIT_L(0); MMA(1, 0, At, B0); MMA(1, 1, At, B1); BAR; }
  { LDB(B0, 1, 0); LDA(At, 1, 0); WAIT_V(2); BAR; WAIT_L(0); MMA(0, 0, At, B0); BAR;
    LDB(B1, 1, 1); WAIT_V(0); BAR; WAIT_L(0); MMA(0, 1, At, B1); BAR;
    LDA(At, 1, 1); BAR; WAIT_L(0); MMA(1, 0, At, B0); MMA(1, 1, At, B1); BAR; }
  if (wr == 0) BAR;
}

DEVI void tile_map(int nM, int nN, int idx, int& pm, int& pn) {
  int nwg = nM * nN; int q = nwg / 8, r = nwg % 8, xcd = idx % 8, off = idx / 8;
  int w = (xcd < r ? xcd * (q + 1) : r * (q + 1) + (xcd - r) * q) + off;
  int nig = 8 * nN, gid = w / nig, fm = gid * 8, gsz = min(nM - fm, 8);
  pm = fm + ((w % nig) % gsz); pn = (w % nig) / gsz;
}

struct ConvJob { const float* src; long ld; u16* dst; long ldd; int zero; };
DEVI void conv_load(const int tid, const ConvJob& j, float4 (&v)[4]) {
  const int rr2 = tid >> 4, cc = (tid & 15) * 4;
  const float* s0 = j.src + (long)(2 * rr2) * j.ld + cc;
  v[0] = ldnt4(s0); v[1] = ldnt4(s0 + j.ld);
  v[2] = ldnt4(s0 + 64); v[3] = ldnt4(s0 + j.ld + 64);
}
DEVI unsigned pk2(float a, float b) { return (unsigned)f2bf(a) | ((unsigned)f2bf(b) << 16); }
DEVI void conv_store(const int tid, unsigned char* smem, const ConvJob& j, const float4 (&v)[4]) {
  unsigned* T = (unsigned*)smem;
  const int rr2 = tid >> 4, cc = (tid & 15) * 4;
  const unsigned zm = j.zero ? 0u : 0xffffffffu;
#define pk2(a, b) (pk2(a, b) & zm)
  T[(cc + 0) * 36 + rr2] = pk2(v[0].x, v[1].x); T[(cc + 1) * 36 + rr2] = pk2(v[0].y, v[1].y);
  T[(cc + 2) * 36 + rr2] = pk2(v[0].z, v[1].z); T[(cc + 3) * 36 + rr2] = pk2(v[0].w, v[1].w);
  T[(cc + 64) * 36 + rr2] = pk2(v[2].x, v[3].x); T[(cc + 65) * 36 + rr2] = pk2(v[2].y, v[3].y);
  T[(cc + 66) * 36 + rr2] = pk2(v[2].z, v[3].z); T[(cc + 67) * 36 + rr2] = pk2(v[2].w, v[3].w);
#undef pk2
  __syncthreads();
#pragma unroll
  for (int h = 0; h < 2; ++h) {
    int n = (tid >> 3) + h * 64, kc = (tid & 7) * 4;
    uint4 o = *(const uint4*)(T + n * 36 + kc);
    *(uint4*)(j.dst + (long)n * j.ldd + kc * 2) = o;
  }
  __syncthreads();
}
DEVI ConvJob conv_job0(KP p, int idx) {
  ConvJob j; j.zero = 0;
  if (idx < 2176) { int nt = idx % 68, kt = idx / 68, n0 = nt * 128; j.zero = (n0 >= 4480 && n0 < 4608); int c0 = n0 < 4480 ? n0 : (j.zero ? 0 : n0 - 128);
    j.src = p->in[I_WIN] + (long)(kt * 64) * 8576 + c0; j.ld = 8576; j.dst = (u16*)(p->ws + OFF_A) + (long)n0 * 2048 + kt * 64; j.ldd = 2048; }
  else { int q = idx - 2176; j.ld = 1024; j.ldd = 384;
    if (q < 32) { int sec = q >> 3, nt = q & 7, d = sec & 1;
      j.src = (sec < 2 ? p->in[I_W2] : p->in[I_A2]) + (long)d * 64 * 1024 + nt * 128; j.dst = (u16*)(p->ws + OFF_LORAT) + (long)(sec * 1024 + nt * 128) * 384 + sec * 64; }
    else { int qq = q - 32, kt = qq >> 3, nt = qq & 7;
      j.src = p->in[I_G2] + (long)(kt * 64) * 1024 + nt * 128; j.dst = (u16*)(p->ws + OFF_LORAT) + (long)(4096 + nt * 128) * 384 + 256 + kt * 64; } }
  return j;
}
DEVI ConvJob conv_job7(KP p, int idx) {
  ConvJob j; j.zero = 0;
  { int kt = idx & 31, nt = (idx >> 5) + 2 * W13A_TILES, n0 = nt * 128, t = n0 >> 8, wi = n0 & 255; int c0 = wi < 128 ? t * 128 : DFF + t * 128;
    j.src = p->in[I_W13] + (long)(kt * 64) * (2 * DFF) + c0; j.ld = 2 * DFF; j.dst = (u16*)(p->ws + OFF_FX) + (long)n0 * 2048 + kt * 64; j.ldd = 2048; }
  return j;
}
DEVI ConvJob conv_job2(KP p, int idx) {
  ConvJob j; j.zero = 0;
  { int kt = idx % 88, nt = idx / 88, n0 = nt * 128;
    j.src = p->in[I_FW2] + (long)(kt * 64) * 2048 + n0; j.ld = 2048; j.dst = (u16*)(p->ws + OFF_W2T) + (long)n0 * DFF + kt * 64; j.ldd = DFF; }
  return j;
}
template <int WHICH>
DEVI void conv_run(KP p, const int tid, unsigned char* smem, int bid, int G) {
  const int njobs = WHICH == 0 ? 2224 : (WHICH == 1 ? (88 - 2 * W13A_TILES) * 32 : 1408);
  int idx = bid;
  if (idx >= njobs) return;
#define CJOB(i) (WHICH == 0 ? conv_job0(p, (i)) : (WHICH == 1 ? conv_job7(p, (i)) : conv_job2(p, (i))))
  ConvJob ja = CJOB(idx); float4 va[4]; conv_load(tid, ja, va);
  for (;;) {
    const int i1 = idx + G; const bool h1 = i1 < njobs;
    float4 vb[4];
    const ConvJob jb = CJOB(h1 ? i1 : idx); conv_load(tid, jb, vb);
    conv_store(tid, smem, ja, va);
    if (!h1) break;
    const int i2 = i1 + G; const bool h2 = i2 < njobs;
    ja = CJOB(h2 ? i2 : i1); conv_load(tid, ja, va);
    conv_store(tid, smem, jb, vb);
    if (!h2) break;
    idx = i2;
  }
#undef CJOB
}

DEVI void row_norm_phase(KP p, const int tid, int mode, int bid, int G) {
  const int lane = tid & 63, wave = tid >> 6;
  const float* MOD = (const float*)(p->ws + OFF_MOD);
  const float* adab = p->in[I_ADAB];
  const int nrows = (mode == 0) ? NTOK : NLAT;
  for (int r = bid * 8 + wave; r < nrows; r += G * 8) {
    const float* src; int mrow;
    if (mode == 0) { if (r < NLAT) { src = p->in[I_X] + (size_t)r * 2048; mrow = r >> 12; } else { src = p->in[I_CTX] + (size_t)(r - NLAT) * 2048; mrow = 2; } }
    else { src = p->out + (size_t)r * 2048; mrow = r >> 12; }
    float4 v[8]; float ss = 0.f;
#pragma unroll
    for (int i = 0; i < 8; ++i) { v[i] = ldnt4(src + (i * 64 + lane) * 4); ss += v[i].x * v[i].x + v[i].y * v[i].y + v[i].z * v[i].z + v[i].w * v[i].w; }
    ss = red64(ss);
    const float rs = rsqrtf(ss * (1.f / 2048.f) + 1e-6f);
    const float* nw = p->in[mode == 0 ? I_N1W : (mode == 1 ? I_N2W : I_NF)];
    const int shoff = (mode == 0) ? 0 : 6144, scoff = (mode == 0) ? 2048 : 8192;
    u16* dstb = (u16*)(p->ws + (mode == 0 ? OFF_B : OFF_A)) + (size_t)r * 2048;
#pragma unroll
    for (int i = 0; i < 8; ++i) {
      int c = (i * 64 + lane) * 4;
      float4 w4 = *(const float4*)(nw + c);
      float y0 = v[i].x * rs * w4.x, y1 = v[i].y * rs * w4.y, y2 = v[i].z * rs * w4.z, y3 = v[i].w * rs * w4.w;
      if (mode == 2) { *(float4*)(p->out + (size_t)r * 2048 + c) = make_float4(y0, y1, y2, y3); }
      else {
        float4 sh = *(const float4*)(MOD + mrow * 12288 + shoff + c), shb = *(const float4*)(adab + shoff + c);
        float4 sc = *(const float4*)(MOD + mrow * 12288 + scoff + c), scb = *(const float4*)(adab + scoff + c);
        y0 = y0 * (1.f + sc.x + scb.x) + sh.x + shb.x; y1 = y1 * (1.f + sc.y + scb.y) + sh.y + shb.y;
        y2 = y2 * (1.f + sc.z + scb.z) + sh.z + shb.z; y3 = y3 * (1.f + sc.w + scb.w) + sh.w + shb.w;
        uint2 o; o.x = (unsigned)f2bf(y0) | ((unsigned)f2bf(y1) << 16); o.y = (unsigned)f2bf(y2) | ((unsigned)f2bf(y3) << 16);
        *(uint2*)(dstb + c) = o;
      }
    }
  }
}

DEVI void phase0(KP p, const int tid, unsigned char* smem, int bid, int G) {
  {
    float* sv = (float*)smem;
    float* red = (float*)(smem + 24576);
    for (int i = tid; i < 3 * 2048; i += NTHR) {
      int j = i >> 11, k = i & 2047;
      float cv = (j < 2) ? p->in[I_C][j * 2048 + k] : p->in[I_CCTX][k];
      sv[i] = silu_(cv);
    }
    __syncthreads();
    float* MOD = (float*)(p->ws + OFF_MOD);
    const float* aw = p->in[I_ADAW];
    for (int cb = bid; cb < 256; cb += G) {
      const int cgq = tid % 12, ksl = tid / 12;
      float a0[4] = {0, 0, 0, 0}, a1[4] = {0, 0, 0, 0}, a2[4] = {0, 0, 0, 0};
      if (tid < 504) {
        const float* wp = aw + cb * 48 + cgq * 4;
#pragma unroll 7
        for (int k = ksl; k < 2048; k += 42) {
          float4 wv = ldnt4(wp + (size_t)k * 12288);
          float s0 = sv[k], s1 = sv[2048 + k], s2 = sv[4096 + k];
          a0[0] += s0 * wv.x; a0[1] += s0 * wv.y; a0[2] += s0 * wv.z; a0[3] += s0 * wv.w;
          a1[0] += s1 * wv.x; a1[1] += s1 * wv.y; a1[2] += s1 * wv.z; a1[3] += s1 * wv.w;
          a2[0] += s2 * wv.x; a2[1] += s2 * wv.y; a2[2] += s2 * wv.z; a2[3] += s2 * wv.w;
        }
        float* rp = red + (ksl * 12 + cgq) * 12;
#pragma unroll
        for (int e = 0; e < 4; ++e) { rp[e] = a0[e]; rp[4 + e] = a1[e]; rp[8 + e] = a2[e]; }
      }
      __syncthreads();
      if (tid < 144) {
        const int j = tid / 48, c = tid % 48;
        float sum = 0.f;
        for (int q = 0; q < 42; ++q) sum += red[(q * 12 + (c >> 2)) * 12 + j * 4 + (c & 3)];
        MOD[j * 12288 + cb * 48 + c] = sum;
      }
      __syncthreads();
    }
  }
  for (int g = G - 1 - bid; g < 64 && g >= 0; g += G) {
    float2* lamp = (float2*)smem;
    float2* bb = (float2*)(smem + 17408);
    float2* cm = (float2*)(smem + 17408 + 16384);
    float* ktab = (float*)(smem + 17408 + 32768);
    for (int i = tid; i < 2 * 17 * 64; i += NTHR) {
      int d = i / (17 * 64), tau = (i / 64) % 17, pp = i & 63;
      float are = p->in[I_SARE][(d * 64 + g) * 64 + pp], aim = p->in[I_SAIM][(d * 64 + g) * 64 + pp];
      float dt = expf(p->in[I_SLDT][d * 64 + g]);
      float re, im; cpow(are, aim, dt, (float)tau, re, im);
      lamp[i] = make_float2(re, im);
    }
    for (int i = tid; i < 2048; i += NTHR) {
      int d = i >> 10, pp = (i >> 4) & 63, h = i & 15;
      float are = p->in[I_SARE][(d * 64 + g) * 64 + pp], aim = p->in[I_SAIM][(d * 64 + g) * 64 + pp];
      float dt = expf(p->in[I_SLDT][d * 64 + g]);
      float lr, li; cpow(are, aim, dt, 1.f, lr, li);
      float nr = lr - 1.f, ni = li, den = 1.f / (are * are + aim * aim);
      float qr = (nr * are + ni * aim) * den, qi = (ni * are - nr * aim) * den;
      float br = p->in[I_SBRE][((size_t)(d * 64 + g) * 64 + pp) * 16 + h], bi = p->in[I_SBIM][((size_t)(d * 64 + g) * 64 + pp) * 16 + h];
      bb[i] = make_float2(qr * br - qi * bi, qr * bi + qi * br);
      int h2 = (i >> 6) & 15, p2 = i & 63;
      cm[i] = make_float2(p->in[I_SCRE][((size_t)(d * 64 + g) * 16 + h2) * 64 + p2], p->in[I_SCIM][((size_t)(d * 64 + g) * 16 + h2) * 64 + p2]);
    }
    __syncthreads();
    {
      const int d = tid >> 8, h = (tid >> 4) & 15, h2 = tid & 15;
      float acc[16];
#pragma unroll
      for (int tau = 0; tau < 16; ++tau) acc[tau] = 0.f;
      for (int pp = 0; pp < 64; ++pp) {
        const float2 c = cm[(d * 16 + h) * 64 + pp], b = bb[(d * 64 + pp) * 16 + h2];
        const float zr = c.x * b.x - c.y * b.y, zi = c.x * b.y + c.y * b.x;
#pragma unroll
        for (int tau = 0; tau < 16; ++tau) { const float2 l = lamp[(d * 17 + tau) * 64 + pp]; acc[tau] += zr * l.x - zi * l.y; }
      }
#pragma unroll
      for (int tau = 0; tau < 16; ++tau) ktab[(d * 16 + tau) * 256 + h * 16 + h2] = acc[tau];
    }
    __syncthreads();
    u16* BM_ = (u16*)(p->ws + OFF_BMAT) + (size_t)g * 65536;
    for (int ch = tid; ch < 8192; ch += NTHR) {
      int n = ch >> 5, k8 = (ch & 31) * 8;
      int d = n >> 7, part = (n >> 6) & 1, pp = n & 63, j = k8 >> 4, h0 = k8 & 15;
      float2 l = lamp[(d * 17 + (d == 0 ? 15 - j : j)) * 64 + pp];
      unsigned o[4];
#pragma unroll
      for (int e = 0; e < 8; ++e) {
        float2 b = bb[(d * 64 + pp) * 16 + h0 + e];
        float val = part == 0 ? (l.x * b.x - l.y * b.y) : (l.x * b.y + l.y * b.x);
        if (e & 1) o[e >> 1] |= (unsigned)f2bf(val) << 16; else o[e >> 1] = f2bf(val);
      }
      *(uint4*)(BM_ + n * 256 + k8) = make_uint4(o[0], o[1], o[2], o[3]);
    }
    u16* KC_ = (u16*)(p->ws + OFF_KC) + (size_t)g * 131072;
    for (int ch = tid; ch < 16384; ch += NTHR) {
      int n = ch >> 6, k8 = (ch & 63) * 8;
      int i = n >> 4, h = n & 15;
      unsigned o[4];
#pragma unroll
      for (int e = 0; e < 8; ++e) {
        int k = k8 + e; float val;
        if (k < 256) {
          int j = k >> 4, h2 = k & 15;
          val = 0.f;
          if (j <= i) val += ktab[(0 * 16 + (i - j)) * 256 + h * 16 + h2];
          if (j >= i) val += ktab[(1 * 16 + (j - i)) * 256 + h * 16 + h2];
          if (j == i && h == h2) val += p->in[I_SD][g * 16 + h];
        } else {
          int kk = k - 256, d = kk >> 7, part = (kk >> 6) & 1, pp = kk & 63;
          int ex = d == 0 ? i + 1 : 16 - i;
          float2 c = cm[(d * 16 + h) * 64 + pp], l = lamp[(d * 17 + ex) * 64 + pp];
          val = part == 0 ? (c.x * l.x - c.y * l.y) : -(c.x * l.y + c.y * l.x);
        }
        if (e & 1) o[e >> 1] |= (unsigned)f2bf(val) << 16; else o[e >> 1] = f2bf(val);
      }
      *(uint4*)(KC_ + n * 512 + k8) = make_uint4(o[0], o[1], o[2], o[3]);
    }
    __syncthreads();
  }
  if (G > 128) { if (bid < G - 64) conv_run<0>(p, tid, smem, bid, G - 64); }
  else conv_run<0>(p, tid, smem, bid, G);
  {
    u16* LT = (u16*)(p->ws + OFF_LORAT);
    for (int ch = bid * NTHR + tid; ch < 5120 * 48; ch += G * NTHR) {
      int n = ch / 48, rem = ch % 48, kb = rem >> 3, part = rem & 7, sec = n >> 10;
      bool nz = (sec < 4) ? (kb == sec) : (kb >= 4);
      if (!nz) *(uint4*)(LT + (size_t)n * 384 + kb * 64 + part * 8) = make_uint4(0, 0, 0, 0);
    }
  }
}

DEVI float red8(float x) { x += dppf<0xB1>(x); x += dppf<0x4E>(x); x += dppf<0x141>(x); return x; }
DEVI void phase3_prep(KP p, const int tid, int bid, int G) {
  const int slot = tid >> 7, t = tid & 127;
  const h16* ZRW = (const h16*)(p->ws + OFF_D);
  h16* Rb = (h16*)(p->ws + OFF_A); h16* Kb = Rb + (size_t)NTOK * 1024;
  h16* Vb = (h16*)(p->ws + OFF_B); h16* KKb = Vb + (size_t)NTOK * 1024;
  u16* LA = (u16*)(p->ws + OFF_LA);
  const float* mu = p->in[I_MU];
  for (int r = bid * 4 + slot; r < NTOK; r += G * 4) {
    int ru, rd, rl, rr; float fu, fd, fl, frr;
    if (r < NLAT) { int l = r & 4095, gr = l >> 6, gc = l & 63;
      fu = gr > 0; fd = gr < 63; fl = gc > 0; frr = gc < 63;
      ru = gr > 0 ? r - 64 : r; rd = gr < 63 ? r + 64 : r; rl = gc > 0 ? r - 1 : r; rr = gc < 63 ? r + 1 : r; }
    else { int l = (r - NLAT) & 255; fu = l > 0; fd = l < 255; fl = 0.f; frr = 0.f; ru = l > 0 ? r - 1 : r; rd = l < 255 ? r + 1 : r; rl = r; rr = r; }
    const float inv = 1.f / (fu + fd + fl + frr);
    fu *= inv; fd *= inv; fl *= inv; frr *= inv;
#define ZS8(c, o) do { h16x8 z_ = *(const h16x8*)(ZRW + (size_t)r * ZRWP + (c)); h16x8 u_ = *(const h16x8*)(ZRW + (size_t)ru * ZRWP + (c)); \
      h16x8 d_ = *(const h16x8*)(ZRW + (size_t)rd * ZRWP + (c)); h16x8 l_ = *(const h16x8*)(ZRW + (size_t)rl * ZRWP + (c)); h16x8 r_ = *(const h16x8*)(ZRW + (size_t)rr * ZRWP + (c)); \
      float4 ma_ = *(const float4*)(mu + (c)), mb_ = *(const float4*)(mu + (c) + 4); \
      const float mm_[8] = {ma_.x, ma_.y, ma_.z, ma_.w, mb_.x, mb_.y, mb_.z, mb_.w}; \
      _Pragma("unroll") for (int e = 0; e < 8; ++e) { float z = (float)z_[e]; \
        float m = fu * (float)u_[e] + fd * (float)d_[e] + fl * (float)l_[e] + frr * (float)r_[e]; o[e] = z + (m - z) * mm_[e]; } } while (0)
    float zr[8], zk[8], zv[8];
    ZS8(8 * t, zr); ZS8(1024 + 8 * t, zk); ZS8(2048 + 8 * t, zv);
    h16x8 o;
#pragma unroll
    for (int e = 0; e < 8; ++e) o[e] = (h16)zr[e];
    *(h16x8*)(Rb + (size_t)r * 1024 + 8 * t) = o;
#pragma unroll
    for (int e = 0; e < 8; ++e) o[e] = (h16)zk[e];
    *(h16x8*)(Kb + (size_t)r * 1024 + 8 * t) = o;
#pragma unroll
    for (int e = 0; e < 8; ++e) o[e] = (h16)zv[e];
    *(h16x8*)(Vb + (size_t)r * 1024 + 8 * t) = o;
    {
      float4 ka_ = *(const float4*)(p->in[I_KK] + 8 * t), kb_ = *(const float4*)(p->in[I_KK] + 8 * t + 4);
      const float kw[8] = {ka_.x, ka_.y, ka_.z, ka_.w, kb_.x, kb_.y, kb_.z, kb_.w};
      float kx[8]; float ss = 0.f;
#pragma unroll
      for (int e = 0; e < 8; ++e) { kx[e] = zk[e] * kw[e]; ss += kx[e] * kx[e]; }
      ss = red8(ss);
      const float rs = rsqrtf(ss + 1e-12f);
#pragma unroll
      for (int e = 0; e < 8; ++e) o[e] = (h16)(kx[e] * rs);
      *(h16x8*)(KKb + (size_t)r * 1024 + 8 * t) = o;
    }
    if (t < 48) {
      float zl[8];
      ZS8(3072 + 8 * t, zl);
      const int c = 8 * t;
      unsigned w[4];
#pragma unroll
      for (int e = 0; e < 8; e += 2) {
        float a = zl[e], b = zl[e + 1];
        if (c < 128) { a = tanh_(a); b = tanh_(b); } else if (c >= 256) { a = sigm(a); b = sigm(b); }
        w[e >> 1] = (unsigned)f2bf(a) | ((unsigned)f2bf(b) << 16);
      }
      *(uint4*)(LA + (size_t)r * 384 + c) = make_uint4(w[0], w[1], w[2], w[3]);
    }
#undef ZS8
  }
}

DEVI void phase4_chunkscan(KP p, const int tid, unsigned char* smem, int bid, int G) {
  const int pp = tid & 63, sl = tid >> 6;
  const float* XLOC = (const float*)p->out;
  u16* U2X = (u16*)(p->ws + OFF_C);
  float2* Fs = (float2*)smem;
  for (int combo = bid; combo < 256; combo += G) {
    const int b = combo >> 7, g = (combo >> 1) & 63, d = combo & 1;
    float are = p->in[I_SARE][(d * 64 + g) * 64 + pp], aim = p->in[I_SAIM][(d * 64 + g) * 64 + pp];
    float dt = expf(p->in[I_SLDT][d * 64 + g]);
    float mr, mi; cpow(are, aim, dt, 16.f, mr, mi);
    float xr[34], xi[34];
#pragma unroll
    for (int i = 0; i < 34; ++i) {
      int q = sl * 34 + i;
      int chunk = q < 16 ? 512 + b * 16 + (d ? 15 - q : q) : b * 256 + (d ? 255 - (q - 16) : (q - 16));
      const float* src = XLOC + ((size_t)g * 544 + chunk) * 256 + d * 128 + pp;
      xr[i] = src[0]; xi[i] = src[64];
    }
    float sr = 0.f, si = 0.f;
#pragma unroll
    for (int i = 0; i < 34; ++i) { float nr = mr * sr - mi * si + xr[i], ni = mr * si + mi * sr + xi[i]; sr = nr; si = ni; }
    Fs[sl * 64 + pp] = make_float2(sr, si);
    float m34r = 1.f, m34i = 0.f;
#pragma unroll
    for (int i = 0; i < 34; ++i) { float nr = m34r * mr - m34i * mi, ni = m34r * mi + m34i * mr; m34r = nr; m34i = ni; }
    __syncthreads();
    float cr = 0.f, ci = 0.f;
#pragma unroll
    for (int s2 = 0; s2 < 7; ++s2) {
      if (s2 < sl) { float2 f = Fs[s2 * 64 + pp]; float nr = m34r * cr - m34i * ci + f.x, ni = m34r * ci + m34i * cr + f.y; cr = nr; ci = ni; }
    }
    sr = cr; si = ci;
#pragma unroll
    for (int i = 0; i < 34; ++i) {
      int q = sl * 34 + i;
      if (q >= 16) {
        int chunk = b * 256 + (d ? 255 - (q - 16) : (q - 16));
        u16* dst = U2X + (size_t)g * GS + (size_t)chunk * 512 + 256 + d * 128 + pp;
        dst[0] = f2bf(sr); dst[64] = f2bf(si);
      }
      float nr = mr * sr - mi * si + xr[i], ni = mr * si + mi * sr + xi[i]; sr = nr; si = ni;
    }
    __syncthreads();
  }
}

struct CJ2 { const float* src; long ld; u16* dst; long ldd; };
DEVI CJ2 cjob_bg(KP p, int idx, int ng) {
  CJ2 j;
  if (idx < 512) { const int nt = idx & 15, kt = idx >> 4, wi = ng * 4; const int sc = wi < 128 ? nt * 128 + wi : 2048 + nt * 128 + wi - 128;
    j.src = p->in[I_GLUW] + (long)(kt * 32) * 4096 + sc; j.ld = 4096; j.dst = (u16*)(p->ws + OFF_GLUT) + (long)(nt * 256 + ng * 4) * 1024 + kt * 32; j.ldd = 1024; }
  else if (idx < 768) { const int q = idx - 512, nt = q & 7, kt = q >> 3;
    j.src = p->in[I_RWP] + (long)(kt * 32) * 2048 + nt * 256 + ng * 4; j.ld = 2048; j.dst = (u16*)(p->ws + OFF_RWPT) + (long)(nt * 256 + ng * 4) * 1024 + kt * 32; j.ldd = 1024; }
  else if (idx < 1280) { const int q = idx - 768, nt = q & 7, kt = q >> 3;
    j.src = p->in[I_WO] + (long)(kt * 32) * 2048 + nt * 256 + ng * 4; j.ld = 2048; j.dst = (u16*)(p->ws + OFF_WOT) + (long)(nt * 256 + ng * 4) * 2048 + kt * 32; j.ldd = 2048; }
  else { const int q = idx - 1280, nt = q % W13A_TILES, kt = q / W13A_TILES, wi = ng * 4; const int sc = wi < 128 ? nt * 128 + wi : DFF + nt * 128 + wi - 128;
    j.src = p->in[I_W13] + (long)(kt * 32) * (2 * DFF) + sc; j.ld = 2 * DFF; j.dst = (u16*)(p->ws + OFF_W13A) + (long)(nt * 256 + ng * 4) * 2048 + kt * 32; j.ldd = 2048; }
  return j;
}
DEVI void cj_load(const CJ2& j, int kg, float4 (&v)[8]) {
  const float* s0 = j.src + (long)(kg * 8) * j.ld;
#pragma unroll
  for (int i = 0; i < 8; ++i) v[i] = ldnt4(s0 + (long)i * j.ld);
}
DEVI void cj_store(const CJ2& j, int kg, const float4 (&v)[8]) {
  u16* d0 = j.dst + kg * 8;
  *(uint4*)(d0) = make_uint4(pk2(v[0].x, v[1].x), pk2(v[2].x, v[3].x), pk2(v[4].x, v[5].x), pk2(v[6].x, v[7].x));
  *(uint4*)(d0 + j.ldd) = make_uint4(pk2(v[0].y, v[1].y), pk2(v[2].y, v[3].y), pk2(v[4].y, v[5].y), pk2(v[6].y, v[7].y));
  *(uint4*)(d0 + 2 * j.ldd) = make_uint4(pk2(v[0].z, v[1].z), pk2(v[2].z, v[3].z), pk2(v[4].z, v[5].z), pk2(v[6].z, v[7].z));
  *(uint4*)(d0 + 3 * j.ldd) = make_uint4(pk2(v[0].w, v[1].w), pk2(v[2].w, v[3].w), pk2(v[4].w, v[5].w), pk2(v[6].w, v[7].w));
}

constexpr int TB = 32, STEPF = 336, BUFB = TB * STEPF * 4, YB_OFF = 2 * BUFB, YG = 16 * 68, YBB = (TB / 4) * YG * 4, NBLK = 4352 / TB;
constexpr int VT_OFF = YB_OFF + 2 * YBB, VTB = 16 * TB * 4;
typedef float f2 __attribute__((ext_vector_type(2)));
DEVI int tokrow(int s, int b, int d) { return s < 256 ? NLAT + b * 256 + (d ? 255 - s : s) : b * 4096 + (d ? 4095 - (s - 256) : (s - 256)); }

template <bool LAT>
DEVI void scan_block(const float* bp, const float* vt, float* yp, int ksl, int rowl, int lin, f2& sa, f2& sb) {
  float4 W[3], KA[3], KD[3], KK[3], R[3];
  float4 V4[8];
#pragma unroll
  for (int i = 0; i < 8; ++i) V4[i] = *(const float4*)(vt + rowl * TB + i * 4);
#define LDSTEP(i, t) do { const float* q_ = bp + (t) * STEPF + ksl * 4; W[i] = *(const float4*)(q_); KA[i] = *(const float4*)(q_ + 64); \
    KD[i] = *(const float4*)(q_ + 128); KK[i] = *(const float4*)(q_ + 192); if (LAT) R[i] = *(const float4*)(q_ + 256); } while (0)
  LDSTEP(0, 0); LDSTEP(1, 1);
  float yacc[4];
#pragma unroll
  for (int t = 0; t < TB; ++t) {
    if (t + 2 < TB) LDSTEP((t + 2) % 3, t + 2);
    const int i = t % 3;
    const f2 kk01 = {KK[i].x, KK[i].y}, kk23 = {KK[i].z, KK[i].w};
    f2 pr = sa * kk01; pr = sb * kk23 + pr;
    const float v = V4[t >> 2][t & 3];
    const f2 vv = {v, v};
    const f2 kd01 = {KD[i].x, KD[i].y}, kd23 = {KD[i].z, KD[i].w}, w01 = {W[i].x, W[i].y}, w23 = {W[i].z, W[i].w};
    const f2 qa = sa * w01 + vv * kd01, qb = sb * w23 + vv * kd23;
    const float u = red16(pr.x + pr.y);
    const f2 uu = {u, u};
    const f2 ka01 = {KA[i].x, KA[i].y}, ka23 = {KA[i].z, KA[i].w};
    sa = qa - uu * ka01; sb = qb - uu * ka23;
    if (LAT) {
      const f2 r01 = {R[i].x, R[i].y}, r23 = {R[i].z, R[i].w};
      f2 y = sa * r01; y = sb * r23 + y;
      yacc[t & 3] = y.x + y.y;
      if ((t & 3) == 3) *(float4*)(yp + (t >> 2) * YG + lin * 4 + (lin >> 4) * 4) = make_float4(yacc[0], yacc[1], yacc[2], yacc[3]);
    }
  }
#undef LDSTEP
}

DEVI void phase5_scan(KP p, const int tid, unsigned char* smem, int bid, int G) {
  for (int unit = bid; unit < 256; unit += G) {
    const int chain = unit >> 2, quarter = unit & 3, b = chain >> 5, head = (chain >> 1) & 15, d = chain & 1;
    const h16* Rb = (const h16*)(p->ws + OFF_A); const h16* Kb = Rb + (size_t)NTOK * 1024;
    const h16* Vb = (const h16*)(p->ws + OFF_B); const h16* KKb = Vb + (size_t)NTOK * 1024;
    const h16* EWb = (const h16*)(p->ws + OFF_FX) + (size_t)d * NTOK * 1024;
    const h16* Ab = (const h16*)(p->ws + OFF_FX) + (size_t)(2 + d) * NTOK * 1024;
    h16* Yd = (h16*)(p->ws + OFF_D) + (size_t)d * NLAT * 1024;
    const bool loader = tid >= 256;
    const int lt = tid - 256, lst = (lt >> 3) & 31, cg8 = lt & 7;
    const int lane = tid & 63, rowl = ((tid >> 6) & 3) * 4 + (lane >> 4), ksl = lane & 15, lin = tid & 255;
    f2 sa = {0.f, 0.f}, sb = {0.f, 0.f};
    float ka[8];
    float4 cv[8];
    const bool bgfirst = (unit == bid);
    constexpr int NBG = 1280 + W13A_TILES * 64;
    const int bg_nsl = (NBG + G - 1) / G;
    h16x8 rR, rK, rKK, rEW, rA; h16x2 rV;
#define LOADRAW(jb) do { int tok_ = tokrow((jb) * TB + lst, b, d); size_t base_ = (size_t)tok_ * 1024 + head * 64 + cg8 * 8; \
      rR = *(const h16x8*)(Rb + base_); rK = *(const h16x8*)(Kb + base_); rKK = *(const h16x8*)(KKb + base_); \
      rEW = *(const h16x8*)(EWb + base_); rA = *(const h16x8*)(Ab + base_); \
      rV = *(const h16x2*)(Vb + (size_t)tok_ * 1024 + head * 64 + quarter * 16 + cg8 * 2); } while (0)
#define CONVERT(bufi) do { float* dst_ = (float*)(smem + (bufi) * BUFB) + lst * STEPF; \
      float fw[8], fkka[8], fkd[8], fkk[8], frv[8]; \
      _Pragma("unroll") for (int e = 0; e < 8; ++e) { float a_ = (float)rA[e], kk_ = (float)rKK[e]; \
        fw[e] = __expf(-(float)rEW[e]); fkka[e] = kk_ * a_; fkd[e] = (float)rK[e] * (1.f + (a_ - 1.f) * ka[e]); fkk[e] = kk_; frv[e] = (float)rR[e]; } \
      *(float4*)(dst_ + cg8 * 8) = make_float4(fw[0], fw[1], fw[2], fw[3]); *(float4*)(dst_ + cg8 * 8 + 4) = make_float4(fw[4], fw[5], fw[6], fw[7]); \
      *(float4*)(dst_ + 64 + cg8 * 8) = make_float4(fkka[0], fkka[1], fkka[2], fkka[3]); *(float4*)(dst_ + 64 + cg8 * 8 + 4) = make_float4(fkka[4], fkka[5], fkka[6], fkka[7]); \
      *(float4*)(dst_ + 128 + cg8 * 8) = make_float4(fkd[0], fkd[1], fkd[2], fkd[3]); *(float4*)(dst_ + 128 + cg8 * 8 + 4) = make_float4(fkd[4], fkd[5], fkd[6], fkd[7]); \
      *(float4*)(dst_ + 192 + cg8 * 8) = make_float4(fkk[0], fkk[1], fkk[2], fkk[3]); *(float4*)(dst_ + 192 + cg8 * 8 + 4) = make_float4(fkk[4], fkk[5], fkk[6], fkk[7]); \
      *(float4*)(dst_ + 256 + cg8 * 8) = make_float4(frv[0], frv[1], frv[2], frv[3]); *(float4*)(dst_ + 256 + cg8 * 8 + 4) = make_float4(frv[4], frv[5], frv[6], frv[7]); \
      { float* vt_ = (float*)(smem + VT_OFF + (bufi) * VTB); vt_[(cg8 * 2) * TB + lst] = (float)rV[0]; vt_[(cg8 * 2 + 1) * TB + lst] = (float)rV[1]; } } while (0)
#define FLUSHY(jb) do { if (lt < 128) { const int t4_ = lt >> 4, row_ = lt & 15; \
      const float* yb_ = (const float*)(smem + YB_OFF + ((jb) & 1) * YBB) + t4_ * YG + row_ * 68; \
      float4 acc_ = *(const float4*)(yb_); \
      _Pragma("unroll") for (int l_ = 1; l_ < 16; ++l_) { const float4 q_ = *(const float4*)(yb_ + l_ * 4); acc_.x += q_.x; acc_.y += q_.y; acc_.z += q_.z; acc_.w += q_.w; } \
      const float ys_[4] = {acc_.x, acc_.y, acc_.z, acc_.w}; \
      _Pragma("unroll") for (int e_ = 0; e_ < 4; ++e_) { const int tok_ = tokrow((jb) * TB + t4_ * 4 + e_, b, d); \
        Yd[(size_t)tok_ * 1024 + head * 64 + quarter * 16 + row_] = (h16)ys_[e_]; } } } while (0)
    if (loader) {
#pragma unroll
      for (int e = 0; e < 8; ++e) ka[e] = p->in[I_KA][head * 64 + cg8 * 8 + e];
      LOADRAW(0); CONVERT(0); LOADRAW(1);
    }
    __syncthreads();
    for (int jb = 0; jb < NBLK; ++jb) {
      if (!loader) {
        const float* bp = (const float*)(smem + (jb & 1) * BUFB);
        float* yp = (float*)(smem + YB_OFF + (jb & 1) * YBB);
        const float* vt = (const float*)(smem + VT_OFF + (jb & 1) * VTB);
        if (jb < 8) scan_block<false>(bp, vt, yp, ksl, rowl, lin, sa, sb);
        else scan_block<true>(bp, vt, yp, ksl, rowl, lin, sa, sb);
      } else {
        if (jb + 1 < NBLK) CONVERT((jb + 1) & 1);
        if (jb + 2 < NBLK) LOADRAW(jb + 2);
        if (jb - 1 >= 8) FLUSHY(jb - 1);
        if (bgfirst && jb >= 10 && jb < 10 + 10 * bg_nsl && bid + G * ((jb - 10) / 10) < NBG) {
          const int ph20 = (jb - 10) % 10, sj = (jb - 10) / 10;
          if (ph20 == 0) { const CJ2 cj = cjob_bg(p, bid + G * sj, lt & 63); cj_load(cj, lt >> 6, cv); }
          else if (ph20 == 1) { const CJ2 cj = cjob_bg(p, bid + G * sj, lt & 63); cj_store(cj, lt >> 6, cv); }
        }
      }
      __syncthreads();
    }
    if (loader) FLUSHY(NBLK - 1);
    __syncthreads();
#undef LOADRAW
#undef CONVERT
#undef FLUSHY
  }
}

DEVI void phase6_post(KP p, const int tid, int bid, int G) {
  const int t = tid;
  const h16* Rb = (const h16*)(p->ws + OFF_A); const h16* Kb = Rb + (size_t)NTOK * 1024;
  const h16* Vb = (const h16*)(p->ws + OFF_B);
  const h16* A0b = (const h16*)(p->ws + OFF_FX) + (size_t)2 * NTOK * 1024; const h16* A1b = A0b + (size_t)NTOK * 1024; const h16* Gb = A1b + (size_t)NTOK * 1024;
  const h16* Y0 = (const h16*)(p->ws + OFF_D); const h16* Y1 = Y0 + (size_t)NLAT * 1024;
  u16* YRW = (u16*)(p->ws + OFF_C);
  const float2 kav = *(const float2*)(p->in[I_KA] + 2 * t), rkv = *(const float2*)(p->in[I_RK] + 2 * t);
  const float2 lw = *(const float2*)(p->in[I_LNW] + 2 * t), lb = *(const float2*)(p->in[I_LNB] + 2 * t);
  for (int r = bid; r < NLAT; r += G) {
    size_t o = (size_t)r * 1024 + 2 * t;
    h16x2 y0 = *(const h16x2*)(Y0 + o), y1 = *(const h16x2*)(Y1 + o);
    float ya = (float)y0[0] + (float)y1[0], yb = (float)y0[1] + (float)y1[1];
    float mean = red32(ya + yb) * (1.f / 64.f);
    float da = ya - mean, db = yb - mean;
    float var = red32(da * da + db * db) * (1.f / 64.f);
    float rs = rsqrtf(var + 64e-5f);
    h16x2 r2 = *(const h16x2*)(Rb + o), k2 = *(const h16x2*)(Kb + o), v2 = *(const h16x2*)(Vb + o);
    h16x2 a0 = *(const h16x2*)(A0b + o), a1 = *(const h16x2*)(A1b + o), g2 = *(const h16x2*)(Gb + o);
    float ra = (float)r2[0], rb = (float)r2[1], ka_ = (float)k2[0], kb_ = (float)k2[1];
    float kd0a = ka_ * (1.f + ((float)a0[0] - 1.f) * kav.x), kd0b = kb_ * (1.f + ((float)a0[1] - 1.f) * kav.y);
    float kd1a = ka_ * (1.f + ((float)a1[0] - 1.f) * kav.x), kd1b = kb_ * (1.f + ((float)a1[1] - 1.f) * kav.y);
    float bs = red32(ra * (kd0a + kd1a) * rkv.x + rb * (kd0b + kd1b) * rkv.y);
    float oa = (da * rs * lw.x + lb.x + bs * (float)v2[0]) * (float)g2[0];
    float ob = (db * rs * lw.y + lb.y + bs * (float)v2[1]) * (float)g2[1];
    *(unsigned*)(YRW + o) = (unsigned)f2bf(oa) | ((unsigned)f2bf(ob) << 16);
  }
}

DEVI void phase7_conv(KP p, const int tid, unsigned char* smem, int bid, int G) { conv_run<1>(p, tid, smem, bid, G); }

#define XB_XCNT(j) (64 * (j))
#define XB_XSUB(j) (1024 + 64 * (j))
#define XB_XGEN(j) (2048 + 64 * (j))
#define XB_TOP 3072
#define XB_TOPGEN 3136
DEVI unsigned xb_ld(unsigned* q) { return __hip_atomic_load(q, __ATOMIC_RELAXED, __HIP_MEMORY_SCOPE_AGENT); }
DEVI unsigned xb_add(unsigned* q, unsigned v) { return __hip_atomic_fetch_add(q, v, __ATOMIC_RELAXED, __HIP_MEMORY_SCOPE_AGENT); }
DEVI unsigned xb_xcc_id() { return (unsigned)__builtin_amdgcn_s_getreg((3 << 11) | 20) & 0xFu; }
DEVI void grid_barrier(unsigned* bar, const unsigned x, const unsigned nloc, const unsigned nx, const int tid) {
  asm volatile("s_waitcnt vmcnt(0) lgkmcnt(0)" ::: "memory");
  __syncthreads();
  if (tid == 0) {
    const unsigned old = xb_add(&bar[XB_XSUB(x)], 1u);
    const unsigned gen = old / nloc;
    if (old + 1u == (gen + 1u) * nloc) {
      __builtin_amdgcn_fence(__ATOMIC_RELEASE, "agent");
      asm volatile("s_waitcnt vmcnt(0)" ::: "memory");
      const unsigned og = xb_add(&bar[XB_TOP], 1u);
      const unsigned tg = og / nx;
      if (og + 1u == (tg + 1u) * nx) xb_add(&bar[XB_TOPGEN], 1u);
      else { while (xb_ld(&bar[XB_TOPGEN]) == tg) __builtin_amdgcn_s_sleep(1); }
      __builtin_amdgcn_fence(__ATOMIC_ACQUIRE, "agent");
      xb_add(&bar[XB_XGEN(x)], 1u);
      asm volatile("s_waitcnt vmcnt(0)" ::: "memory");
    } else {
      while (xb_ld(&bar[XB_XGEN(x)]) == gen) __builtin_amdgcn_s_sleep(1);
      __builtin_amdgcn_fence(__ATOMIC_ACQUIRE, "agent");
      asm volatile("s_waitcnt vmcnt(0)" ::: "memory");
    }
  }
  __syncthreads();
}

template <int ph>
DEVI void run_phase(KP p, const int wv, const int tid, const int bid, const int G, unsigned char* smem) {
  {
    switch (ph) {
      case 0: phase0(p, tid, smem, bid, G); break;
      case 1: row_norm_phase(p, tid, 0, bid, G); break;
      case 3: phase3_prep(p, tid, bid, G); break;
      case 4: phase4_chunkscan(p, tid, smem, bid, G); break;
      case 5: phase5_scan(p, tid, smem, bid, G); break;
      case 6: phase6_post(p, tid, bid, G); break;
      case 7: phase7_conv(p, tid, smem, bid, G); break;
      case 9: row_norm_phase(p, tid, 1, bid, G); break;
      case 12: row_norm_phase(p, tid, 2, bid, G); break;
      default: break;
    }
    int nunits = 0, nsub = 1;
    switch (ph) {
      case 2: nunits = 1124; break;
      case 3: nunits = 192; break;
      case 4: nunits = 680; break;
      case 5: nunits = 128; break;
      case 7: nunits = 256; nsub = 3; break;
      case 8: nunits = 256; break;
      case 10: nunits = 1408; break;
      case 11: nunits = 256; break;
      default: break;
    }
    if (nunits > 0) __syncthreads();
    for (int it0 = 0;; ++it0) {
      const int unit = bid + it0 * G;
      if (unit >= nunits) break;
#pragma unroll
     for (int sub = 0; sub < (ph == 7 ? 3 : 1); ++sub) {
      const u16* A = nullptr; const u16* Bt = nullptr; long lda = 0, ldb = 0; int K = 0, brow = 0, bcol = 0, pm = 0, pn = 0, e0 = 0;
      switch (ph) {
        case 2:
          if (unit < 1088) { tile_map(32, 34, unit, pm, pn); brow = pm * 256; } else { tile_map(2, 18, unit - 1088, pm, pn); brow = NLAT + pm * 256; }
          A = (const u16*)(p->ws + OFF_B); lda = 2048; Bt = (const u16*)(p->ws + OFF_A); ldb = 2048; K = 2048; bcol = pn * 256; break;
        case 3:
          e0 = unit / 3; pm = unit % 3; A = (const u16*)(p->ws + OFF_C) + (size_t)e0 * GS; lda = 512; brow = pm * 256;
          Bt = (const u16*)(p->ws + OFF_BMAT) + (size_t)e0 * 65536; ldb = 256; K = 256; bcol = 0; break;
        case 4:
          tile_map(34, 20, unit, pm, pn); { const int kwin = pn < 8 ? 0 : (pn < 16 ? 128 : 256);
          A = (const u16*)(p->ws + OFF_LA) + kwin; lda = 384; brow = pm * 256;
          Bt = (const u16*)(p->ws + OFF_LORAT) + kwin; ldb = 384; K = 128; bcol = pn * 256; } break;
        case 5:
          e0 = unit >> 1; pm = unit & 1; A = (const u16*)(p->ws + OFF_C) + (size_t)e0 * GS; lda = 512; brow = pm * 256;
          Bt = (const u16*)(p->ws + OFF_KC) + (size_t)e0 * 131072; ldb = 512; K = 512; bcol = 0; break;
        case 7:
          tile_map(32, 8, unit, pm, pn); brow = pm * 256; lda = 1024; ldb = 1024; K = 1024;
          if (sub < 2) { A = (const u16*)(p->ws + OFF_D + 33554432); Bt = (const u16*)(p->ws + OFF_GLUT); bcol = (pn * 2 + sub) * 256; }
          else { A = (const u16*)(p->ws + OFF_C); Bt = (const u16*)(p->ws + OFF_RWPT); bcol = pn * 256; }
          break;
        case 8:
          tile_map(32, 8, unit, pm, pn); A = (const u16*)(p->ws + OFF_B); lda = 2048; brow = pm * 256;
          Bt = (const u16*)(p->ws + OFF_WOT); ldb = 2048; K = 2048; bcol = pn * 256; break;
        case 10:
          tile_map(32, 44, unit, pm, pn); A = (const u16*)(p->ws + OFF_A); lda = 2048; brow = pm * 256;
          Bt = (const u16*)(p->ws + (pn < W13A_TILES ? OFF_W13A : OFF_FX)); ldb = 2048; K = 2048; bcol = pn * 256; break;
        default:
          tile_map(32, 8, unit, pm, pn); A = (const u16*)(p->ws + OFF_C); lda = DFF; brow = pm * 256;
          Bt = (const u16*)(p->ws + OFF_W2T); ldb = DFF; K = DFF; bcol = pn * 256; break;
      }
      f32x4 acc[2][2][4][2];
      gemm_core(wv, (u16*)smem, A, lda, Bt, ldb, K, brow, bcol, acc);
      const int te = wv * 64 + lane_id_opaque();
      const int wid = te >> 6, lane = te & 63, wr = wid >> 2, wc = wid & 3, fr = lane & 15, fq = lane >> 4;
#define QWRITE(Tp, ai, bj) _Pragma("unroll") for (int m = 0; m < 4; ++m) _Pragma("unroll") for (int n = 0; n < 2; ++n) _Pragma("unroll") for (int j = 0; j < 4; ++j) \
        (Tp)[(wr * 64 + m * 16 + fq * 4 + j) * 132 + wc * 32 + n * 16 + fr] = acc[ai][bj][m][n][j];
#define EPI_ALL(BODY) _Pragma("unroll") for (int ai = 0; ai < 2; ++ai) _Pragma("unroll") for (int bj = 0; bj < 2; ++bj) { __builtin_amdgcn_sched_barrier(0); \
      _Pragma("unroll") for (int m = 0; m < 4; ++m) _Pragma("unroll") for (int n = 0; n < 2; ++n) _Pragma("unroll") for (int j = 0; j < 4; ++j) { \
        const int row = brow + ai * 128 + wr * 64 + m * 16 + fq * 4 + j; const int col = bcol + bj * 128 + wc * 32 + n * 16 + fr; \
        const float v = acc[ai][bj][m][n][j]; BODY } }
#define EPI_HALF(BODY) _Pragma("unroll") for (int ai = 0; ai < 2; ++ai) { __builtin_amdgcn_sched_barrier(0); \
      _Pragma("unroll") for (int m = 0; m < 4; ++m) _Pragma("unroll") for (int n = 0; n < 2; ++n) _Pragma("unroll") for (int j = 0; j < 4; ++j) { \
        const int row = brow + ai * 128 + wr * 64 + m * 16 + fq * 4 + j; const int cw = wc * 32 + n * 16 + fr; \
        const float v0 = acc[ai][0][m][n][j]; const float v1 = acc[ai][1][m][n][j]; BODY } }
      switch (ph) {
        case 2: {
          if (pn < 4) { u16* U2X = (u16*)(p->ws + OFF_C);
            EPI_ALL({ U2X[(size_t)(col >> 4) * GS + (size_t)(row >> 4) * 512 + (row & 15) * 16 + (col & 15)] = f2bf(v); }) }
          else if (pn < 18) { h16* ZRW = (h16*)(p->ws + OFF_D);
            EPI_ALL({ ZRW[(size_t)row * ZRWP + (col - 1024)] = (h16)v; }) }
          else { u16* GT = (u16*)(p->ws + OFF_E);
            EPI_ALL({ GT[(size_t)row * 4096 + (col - 4608)] = f2bf(sigm(v)); }) }
        } break;
        case 3: { float* XLOC = p->out;
          EPI_ALL({ if (row < 544) XLOC[((size_t)e0 * 544 + row) * 256 + col] = v; }) } break;
        case 4: {
          const int sec = pn >> 2;
          h16* dst = (h16*)(p->ws + OFF_FX) + (size_t)sec * NTOK * 1024;
          if (sec < 2) { const float* w0 = p->in[I_W0] + sec * 1024;
            EPI_ALL({ const int c = col & 1023; dst[(size_t)row * 1024 + c] = (h16)(0.6065306597126334f * sigm(w0[c] + v)); }) }
          else if (sec < 4) { const float* a0 = p->in[I_A0] + (sec - 2) * 1024;
            EPI_ALL({ const int c = col & 1023; dst[(size_t)row * 1024 + c] = (h16)sigm(a0[c] + v); }) }
          else { EPI_ALL({ const int c = col & 1023; dst[(size_t)row * 1024 + c] = (h16)v; }) }
        } break;
        case 5: { u16* YS = (u16*)(p->ws + OFF_D + 33554432);
          EPI_ALL({ YS[(size_t)(row * 16 + (col >> 4)) * 1024 + e0 * 16 + (col & 15)] = f2bf(gelu_tanh(v)); }) } break;
        case 7: {
          const u16* GT = (const u16*)(p->ws + OFF_E); float* M1 = p->out;
          float* T0 = (float*)smem; float* T1 = (float*)smem + 128 * 132;
          const int c4 = te & 31, r0 = te >> 5;
          if (sub < 2) {
#pragma unroll
            for (int ai = 0; ai < 2; ++ai) {
              QWRITE(T0, ai, 0); QWRITE(T1, ai, 1);
              __syncthreads();
              const int cm_ = pn * 256 + sub * 128 + c4 * 4;
              uint2 gg[8];
#pragma unroll
              for (int i = 0; i < 8; ++i) gg[i] = *(const uint2*)(GT + (size_t)(brow + ai * 128 + r0 + i * 16) * 4096 + cm_);
#pragma unroll
              for (int i = 0; i < 8; ++i) {
                const int r = r0 + i * 16;
                const float4 a = *(const float4*)(T0 + r * 132 + c4 * 4), bq = *(const float4*)(T1 + r * 132 + c4 * 4);
                float4 o;
                o.x = a.x * sigm(bq.x) * bf2f((u16)(gg[i].x & 0xffffu)); o.y = a.y * sigm(bq.y) * bf2f((u16)(gg[i].x >> 16));
                o.z = a.z * sigm(bq.z) * bf2f((u16)(gg[i].y & 0xffffu)); o.w = a.w * sigm(bq.w) * bf2f((u16)(gg[i].y >> 16));
                uint2 ob; ob.x = (unsigned)f2bf(o.x) | ((unsigned)f2bf(o.y) << 16); ob.y = (unsigned)f2bf(o.z) | ((unsigned)f2bf(o.w) << 16);
                *(uint2*)((u16*)M1 + (size_t)(brow + ai * 128 + r) * 2048 + cm_) = ob;
              }
              __syncthreads();
            }
          } else { u16* MG = (u16*)(p->ws + OFF_B);
#pragma unroll
            for (int ai = 0; ai < 2; ++ai)
#pragma unroll
              for (int bj = 0; bj < 2; ++bj) {
                QWRITE(T0, ai, bj);
                __syncthreads();
                const int col = bcol + bj * 128 + c4 * 4;
                uint2 gg[8]; float4 mm[8];
#pragma unroll
                for (int i = 0; i < 8; ++i) { const size_t row = (size_t)(brow + ai * 128 + r0 + i * 16);
                  gg[i] = *(const uint2*)(GT + row * 4096 + 2048 + col); const uint2 mb_ = *(const uint2*)((const u16*)M1 + row * 2048 + col);
                  mm[i] = make_float4(bf2f((u16)(mb_.x & 0xffffu)), bf2f((u16)(mb_.x >> 16)), bf2f((u16)(mb_.y & 0xffffu)), bf2f((u16)(mb_.y >> 16))); }
#pragma unroll
                for (int i = 0; i < 8; ++i) {
                  const int r = r0 + i * 16;
                  const float4 a = *(const float4*)(T0 + r * 132 + c4 * 4);
                  const float o0 = mm[i].x + bf2f((u16)(gg[i].x & 0xffffu)) * a.x, o1 = mm[i].y + bf2f((u16)(gg[i].x >> 16)) * a.y;
                  const float o2 = mm[i].z + bf2f((u16)(gg[i].y & 0xffffu)) * a.z, o3 = mm[i].w + bf2f((u16)(gg[i].y >> 16)) * a.w;
                  uint2 o; o.x = (unsigned)f2bf(o0) | ((unsigned)f2bf(o1) << 16); o.y = (unsigned)f2bf(o2) | ((unsigned)f2bf(o3) << 16);
                  *(uint2*)(MG + (size_t)(brow + ai * 128 + r) * 2048 + col) = o;
                }
                __syncthreads();
              }
          }
        } break;
        case 8: { const float* MOD = (const float*)(p->ws + OFF_MOD); const float* ab = p->in[I_ADAB]; const float* x = p->in[I_X];
          float* T0 = (float*)smem; const int c4 = te & 31, r0 = te >> 5;
#pragma unroll
          for (int ai = 0; ai < 2; ++ai)
#pragma unroll
            for (int bj = 0; bj < 2; ++bj) {
              QWRITE(T0, ai, bj);
              __syncthreads();
              const int col = bcol + bj * 128 + c4 * 4;
              const float4 ga = *(const float4*)(MOD + (brow >> 12) * 12288 + 4096 + col), gb = *(const float4*)(ab + 4096 + col);
              float4 xx[8];
#pragma unroll
              for (int i = 0; i < 8; ++i) xx[i] = *(const float4*)(x + (size_t)(brow + ai * 128 + r0 + i * 16) * 2048 + col);
#pragma unroll
              for (int i = 0; i < 8; ++i) {
                const int r = r0 + i * 16;
                const float4 a = *(const float4*)(T0 + r * 132 + c4 * 4);
                float4 o; o.x = xx[i].x + (ga.x + gb.x) * a.x; o.y = xx[i].y + (ga.y + gb.y) * a.y; o.z = xx[i].z + (ga.z + gb.z) * a.z; o.w = xx[i].w + (ga.w + gb.w) * a.w;
                *(float4*)(p->out + (size_t)(brow + ai * 128 + r) * 2048 + col) = o;
              }
              __syncthreads();
            }
        } break;
        case 10: { u16* ACT = (u16*)(p->ws + OFF_C);
          EPI_HALF({ ACT[(size_t)row * DFF + pn * 128 + cw] = f2bf(silu_(v0) * v1); }) } break;
        default: { const float* MOD = (const float*)(p->ws + OFF_MOD); const float* ab = p->in[I_ADAB];
          float* T0 = (float*)smem; const int c4 = te & 31, r0 = te >> 5;
#pragma unroll
          for (int ai = 0; ai < 2; ++ai)
#pragma unroll
            for (int bj = 0; bj < 2; ++bj) {
              QWRITE(T0, ai, bj);
              __syncthreads();
              const int col = bcol + bj * 128 + c4 * 4;
              const float4 ga = *(const float4*)(MOD + (brow >> 12) * 12288 + 10240 + col), gb = *(const float4*)(ab + 10240 + col);
              float4 xx[8];
#pragma unroll
              for (int i = 0; i < 8; ++i) xx[i] = *(const float4*)(p->out + (size_t)(brow + ai * 128 + r0 + i * 16) * 2048 + col);
#pragma unroll
              for (int i = 0; i < 8; ++i) {
                const int r = r0 + i * 16;
                const float4 a = *(const float4*)(T0 + r * 132 + c4 * 4);
                float4 o; o.x = xx[i].x + (ga.x + gb.x) * a.x; o.y = xx[i].y + (ga.y + gb.y) * a.y; o.z = xx[i].z + (ga.z + gb.z) * a.z; o.w = xx[i].w + (ga.w + gb.w) * a.w;
                *(float4*)(p->out + (size_t)(brow + ai * 128 + r) * 2048 + col) = o;
              }
              __syncthreads();
            }
        } break;
      }
     }
    }
    if (ph == 2 && G > 100 && bid >= 100) { __syncthreads(); conv_run<2>(p, wv * 64 + lane_id_opaque(), smem, bid - 100, G - 100); }
  }
}

__global__ void __launch_bounds__(NTHR, 2) mega(Params p_arg) {
  extern __shared__ __attribute__((aligned(16))) unsigned char smem[];
  const int G = gridDim.x;
  const int ph_lo = p_arg.ph_lo, ph_hi = p_arg.ph_hi;
  const int wv = __builtin_amdgcn_readfirstlane((int)threadIdx.x >> 6);
  const unsigned xcc = xb_xcc_id();
  unsigned nloc = 1u, nx = 1u;
  if (ph_hi > 1000) cg::this_grid().sync();
  if (ph_hi - ph_lo > 1) {
    unsigned* bar = (unsigned*)(p_arg.ws + OFF_XB);
    if (threadIdx.x == 0) (void)xb_add(&bar[XB_XCNT(xcc)], 1u);
  }
#define PHASE(k) if (ph_lo <= (k) && (k) < ph_hi) { \
    const int tid = wv * 64 + lane_id_opaque(); \
    int bid = blockIdx.x; asm volatile("" : "+s"(bid)); \
    KP p = (KP)__builtin_amdgcn_kernarg_segment_ptr(); asm volatile("" : "+s"(p)); \
    run_phase<k>(p, wv, tid, bid, G, smem); \
    if ((k) + 1 < ph_hi) { if ((k) == 0) {   \
        unsigned* bar = (unsigned*)(p->ws + OFF_XB); \
        if (wv * 64 + lane_id_opaque() == 0) { for (;;) { unsigned sum = 0u; _Pragma("unroll") for (unsigned j = 0; j < 16; ++j) sum += xb_ld(&bar[XB_XCNT(j)]); if (sum == (unsigned)G) break; __builtin_amdgcn_s_sleep(1); } } \
        __syncthreads(); \
        unsigned mine = 0u, cnt = 0u; \
        _Pragma("unroll") for (unsigned j = 0; j < 16; ++j) { const unsigned c = xb_ld(&bar[XB_XCNT(j)]); cnt += (c > 0u) ? 1u : 0u; mine = (j == xcc) ? c : mine; } \
        nloc = (unsigned)__builtin_amdgcn_readfirstlane((int)(mine > 0u ? mine : 1u)); nx = (unsigned)__builtin_amdgcn_readfirstlane((int)(cnt > 0u ? cnt : 1u)); } \
      grid_barrier((unsigned*)(p->ws + OFF_XB), xcc, nloc, nx, wv * 64 + lane_id_opaque()); } }
  PHASE(0) PHASE(1) PHASE(2) PHASE(3) PHASE(4) PHASE(5) PHASE(6) PHASE(7) PHASE(8) PHASE(9) PHASE(10) PHASE(11) PHASE(12)
}

extern "C" void kernel_launch(void* const* d_in, const int* in_sizes, int n_in, void* d_out, int out_size, void* d_ws, size_t ws_size,
                              hipStream_t stream) {
  constexpr int LDS_BYTES = 159744;
  static int grid = 0;
  if (grid == 0) {
    if (n_in != 34 || ws_size < WS_END) { fprintf(stderr, "kernel_launch: bad args n_in %d ws %zu (need %zu)\n", n_in, ws_size, (size_t)WS_END); grid = -1; return; }
    int dev = 0, cus = 0, per_cu = 0;
    hipGetDevice(&dev);
    hipDeviceGetAttribute(&cus, hipDeviceAttributeMultiprocessorCount, dev);
    if (hipFuncSetAttribute((const void*)mega, hipFuncAttributeMaxDynamicSharedMemorySize, LDS_BYTES) != hipSuccess) { fprintf(stderr, "hipFuncSetAttribute failed\n"); grid = -1; return; }
    hipOccupancyMaxActiveBlocksPerMultiprocessor(&per_cu, (const void*)mega, NTHR, LDS_BYTES);
    (void)hipGetLastError();
    if (per_cu < 1) per_cu = 1;
    grid = cus;
    fprintf(stderr, "kernel_launch: cus %d per_cu %d grid %d ws %zu\n", cus, per_cu, grid, ws_size);
  }
  if (grid < 0) return;
  hipMemsetAsync((char*)d_ws + OFF_XB, 0, 16384, stream);
  Params p{};
  for (int i = 0; i < 34; ++i) p.in[i] = (const float*)d_in[i];
  p.out = (float*)d_out; p.ws = (unsigned char*)d_ws;
#if ONE_LAUNCH
  p.ph_lo = 0; p.ph_hi = 13;
  void* args[] = {&p};
  hipError_t e = hipLaunchCooperativeKernel((const void*)mega, dim3(grid), dim3(NTHR), args, LDS_BYTES, stream);
  if (e != hipSuccess) fprintf(stderr, "cooperative launch failed: %s\n", hipGetErrorString(e));
#else
  for (int ph = 0; ph < 13; ++ph) {
    p.ph_lo = ph; p.ph_hi = ph + 1;
    hipLaunchKernelGGL(mega, dim3(grid), dim3(NTHR), LDS_BYTES, stream, p);
  }
#endif
}
```
